# Optimizing an MI355X kernel written in HIP

```python
import math
import jax, jax.numpy as jnp
from jax import lax
import numpy as np

D_MODEL = 2048
BATCH = 1
SEQ = 16384
DEPTH = 2
DEC_BATCH = 8
DEC_SEQ = 64
PAST_LEN = 1024

CHUNK = 64
N_A = DEPTH // 2
N_B = DEPTH - N_A
MEM_LEN = 256
HEAD_DIM = 128
MEM_HEADS = 4
MEM_WIDTH = MEM_HEADS * HEAD_DIM
MIX_WIDTH = D_MODEL - MEM_WIDTH
GDN_HEADS = MIX_WIDTH // HEAD_DIM
CONV_WIDTH = 4
CONV_DIM = 3 * MIX_WIDTH
DIFF_HEADS = MIX_WIDTH // (2 * HEAD_DIM)
DIFF_DK = HEAD_DIM
DIFF_DV = 2 * HEAD_DIM
D_FF = 5632
N_BUCKETS = 32
MAX_DISTANCE = 128
Q_BLOCK = 128
EPS = 1e-6
IN_A = CONV_DIM + MIX_WIDTH + 2 * GDN_HEADS + MEM_WIDTH
IN_B = 2 * DIFF_HEADS * DIFF_DK + MEM_WIDTH
KV_B = 2 * DIFF_HEADS * DIFF_DK + DIFF_HEADS * DIFF_DV

kernel_name = 'yoco_gdn_diffattn_stream_step'


def rmsnorm(x, g):
    xf = x.astype(jnp.float32)
    y = xf * lax.rsqrt(jnp.mean(xf * xf, axis=-1, keepdims=True) + EPS)
    return (y * g.astype(jnp.float32)).astype(x.dtype)


def l2norm(x):
    return x * lax.rsqrt(jnp.sum(x * x, axis=-1, keepdims=True) + EPS)


def swiglu(x, w_gu, w_down):
    gate, up = jnp.split(x @ w_gu, 2, axis=-1)
    return (jax.nn.silu(gate) * up) @ w_down


def causal_conv(x, buf, w):
    T = x.shape[1]
    xp = jnp.concatenate([buf.astype(x.dtype), x], axis=1)
    y = sum(xp[:, j:j + T] * w[j] for j in range(CONV_WIDTH))
    return jax.nn.silu(y), xp[:, T:]


def gated_delta_rule(q, k, v, g, beta, state):
    B, T, H, DK = k.shape
    pad = (-T) % CHUNK

    def to_chunks(a):
        a = jnp.pad(a, [(0, 0), (0, pad)] + [(0, 0)] * (a.ndim - 2))
        a = a.reshape((B, (T + pad) // CHUNK, CHUNK) + a.shape[2:])
        return jnp.moveaxis(a, 3, 1)

    q, k, v, g, beta = (to_chunks(a) for a in (q, k, v, g, beta))
    q = q * DK ** -0.5
    g = jnp.cumsum(g, axis=-1)
    incl = jnp.tril(jnp.ones((CHUNK, CHUNK), dtype=bool))
    strict = jnp.tril(jnp.ones((CHUNK, CHUNK), dtype=bool), -1)
    decay = jnp.where(incl, jnp.exp(jnp.where(incl, g[..., :, None] - g[..., None, :], 0.0)), 0.0)
    k_beta = k * beta[..., None]
    L = jnp.where(strict, jnp.einsum('bhncd,bhnsd->bhncs', k_beta, k) * decay, 0.0)
    eye = jnp.eye(CHUNK, dtype=L.dtype)
    t_inv = lax.linalg.triangular_solve(eye + L, jnp.broadcast_to(eye, L.shape),
                                        left_side=True, lower=True, unit_diagonal=True)
    u = jnp.einsum('bhncs,bhnse->bhnce', t_inv, v * beta[..., None])
    w = jnp.einsum('bhncs,bhnsd->bhncd', t_inv, k_beta * jnp.exp(g)[..., None])
    a_intra = jnp.where(incl, jnp.einsum('bhncd,bhnsd->bhncs', q, k) * decay, 0.0)
    g_last = g[..., -1:]
    xs = (q * jnp.exp(g)[..., None], k * jnp.exp(g_last - g)[..., None], u, w, a_intra,
          jnp.exp(g_last[..., 0]))
    xs = tuple(jnp.moveaxis(a, 2, 0) for a in xs)

    def step(S, inp):
        qg, kd, u_c, w_c, a_c, gl = inp
        v_new = u_c - jnp.einsum('bhcd,bhde->bhce', w_c, S)
        o = jnp.einsum('bhcd,bhde->bhce', qg, S) + jnp.einsum('bhcs,bhse->bhce', a_c, v_new)
        S = S * gl[..., None, None] + jnp.einsum('bhcd,bhce->bhde', kd, v_new)
        return S, o

    S, o = lax.scan(step, state, xs)
    o = jnp.transpose(o, (1, 0, 3, 2, 4)).reshape(B, T + pad, H, -1)[:, :T]
    return o, S


def memory_kv(mem, g, w):
    B, M, _ = mem.shape
    k, v = jnp.split(rmsnorm(mem, g) @ w, 2, axis=-1)
    return k.reshape(B, M, MEM_HEADS, HEAD_DIM), v.reshape(B, M, MEM_HEADS, HEAD_DIM)


def memory_attend(qm, mem_k, mem_v):
    B, T, _ = qm.shape
    q = qm.reshape(B, T, MEM_HEADS, HEAD_DIM)
    s = jnp.einsum('bthd,bmhd->bhtm', q, mem_k.astype(q.dtype)).astype(jnp.float32) * HEAD_DIM ** -0.5
    p = jax.nn.softmax(s, axis=-1).astype(q.dtype)
    return jnp.einsum('bhtm,bmhd->bthd', p, mem_v.astype(q.dtype)).reshape(B, T, MEM_WIDTH)


def rel_bucket(rel):
    nb = N_BUCKETS // 2
    max_exact = nb // 2
    n = jnp.abs(rel)
    large = max_exact + (jnp.log(jnp.maximum(n, 1).astype(jnp.float32) / max_exact)
                         / math.log(MAX_DISTANCE / max_exact) * (nb - max_exact)).astype(jnp.int32)
    large = jnp.minimum(large, nb - 1)
    return jnp.where(rel > 0, nb, 0) + jnp.where(n < max_exact, n, large)


def diff_attend(q, k, v, q_pos, k_pos, lam, rel_table):
    s = jnp.einsum('bqhmd,bkhmd->bhmqk', q, k).astype(jnp.float32) * DIFF_DK ** -0.5
    rel = k_pos[None, :] - q_pos[:, None]
    bias = jnp.transpose(rel_table[rel_bucket(rel)], (2, 0, 1)).astype(jnp.float32)
    visible = (k_pos[None, :] // CHUNK) <= (q_pos[:, None] // CHUNK)
    s = jnp.where(visible, s + bias[None, :, None], -1e30)
    p = jax.nn.softmax(s, axis=-1)
    a = p[:, :, 0] - lam * p[:, :, 1]
    return jnp.einsum('bhqk,bkhe->bqhe', a.astype(v.dtype), v)


def lambda_init(layer_idx):
    return 0.8 - 0.6 * math.exp(-0.3 * layer_idx)


def mixer_a(xn, conv_buf, S0, w_in, conv_w, a_log, dt_bias, onorm, mem_k, mem_v):
    B, T, _ = xn.shape
    proj = xn @ w_in
    qkv, z, b_logit, a_logit, qm = jnp.split(
        proj, [CONV_DIM, CONV_DIM + MIX_WIDTH, CONV_DIM + MIX_WIDTH + GDN_HEADS,
               CONV_DIM + MIX_WIDTH + 2 * GDN_HEADS], axis=-1)
    qkv, new_buf = causal_conv(qkv, conv_buf, conv_w)
    q, k, v = (t.reshape(B, T, GDN_HEADS, HEAD_DIM).astype(jnp.float32) for t in jnp.split(qkv, 3, axis=-1))
    q, k = l2norm(q), l2norm(k)
    beta = jax.nn.sigmoid(b_logit.astype(jnp.float32))
    g = -jnp.exp(a_log.astype(jnp.float32)) * jax.nn.softplus(a_logit.astype(jnp.float32) + dt_bias.astype(jnp.float32))
    o, S = gated_delta_rule(q, k, v, g, beta, S0.astype(jnp.float32))
    o = rmsnorm(o, onorm) * jax.nn.silu(z.reshape(B, T, GDN_HEADS, HEAD_DIM).astype(jnp.float32))
    o = o.reshape(B, T, MIX_WIDTH).astype(xn.dtype)
    m = memory_attend(qm, mem_k, mem_v)
    return jnp.concatenate([o, m], axis=-1), new_buf, S.astype(xn.dtype)


def mixer_b(xn, q_pos, k_all, v_all, k_pos, w_in, lam_qk, subln, lam0, rel_table, mem_k, mem_v, blocked):
    B, T, _ = xn.shape
    proj = xn @ w_in
    q = proj[..., :2 * DIFF_HEADS * DIFF_DK].reshape(B, T, DIFF_HEADS, 2, DIFF_DK)
    qm = proj[..., 2 * DIFF_HEADS * DIFF_DK:]
    lq = lam_qk.astype(jnp.float32)
    lam = jnp.exp(jnp.sum(lq[0] * lq[1])) - jnp.exp(jnp.sum(lq[2] * lq[3])) + lam0
    if blocked:
        nb = T // Q_BLOCK
        qb = jnp.moveaxis(q.reshape(B, nb, Q_BLOCK, DIFF_HEADS, 2, DIFF_DK), 1, 0)
        pb = q_pos.reshape(nb, Q_BLOCK)
        o = lax.map(lambda a: diff_attend(a[0], k_all, v_all, a[1], k_pos, lam, rel_table), (qb, pb))
        o = jnp.moveaxis(o, 0, 1).reshape(B, T, DIFF_HEADS, DIFF_DV)
    else:
        o = diff_attend(q, k_all, v_all, q_pos, k_pos, lam, rel_table)
    o = (rmsnorm(o, subln) * (1.0 - lam0)).reshape(B, T, MIX_WIDTH)
    m = memory_attend(qm, mem_k, mem_v)
    return jnp.concatenate([o, m], axis=-1)


def run_group(x, q_pos, mem_k, mem_v, conv_states, delta_states, past_k, past_v, blocked, W):
    B, T, _ = x.shape
    h = x
    new_conv, new_delta = [], []
    for l in range(DEPTH):
        ng = W['norm_gains'][l]
        if l == N_A:
            kv = rmsnorm(h, W['kv_norm']) @ W['w_kv']
            k_new = kv[..., :2 * DIFF_HEADS * DIFF_DK].reshape(B, T, DIFF_HEADS, 2, DIFF_DK)
            v_new = kv[..., 2 * DIFF_HEADS * DIFF_DK:].reshape(B, T, DIFF_HEADS, DIFF_DV)
            if past_k is None:
                k_all, v_all = k_new, v_new
            else:
                k_all = jnp.concatenate([past_k.astype(k_new.dtype), k_new], axis=1)
                v_all = jnp.concatenate([past_v.astype(v_new.dtype), v_new], axis=1)
            k_pos = jnp.arange(k_all.shape[1])
        h = h + 0.5 * rmsnorm(swiglu(rmsnorm(h, ng[0]), W['ffn_gate_up'][l, 0], W['ffn_down'][l, 0]), ng[1])
        xn = rmsnorm(h, ng[2])
        if l < N_A:
            mix, cb, S = mixer_a(xn, conv_states[l], delta_states[l], W['w_in_a'][l], W['conv_w_a'][l],
                                 W['a_log'][l], W['dt_bias'][l], W['onorm_a'][l], mem_k[l], mem_v[l])
            new_conv.append(cb)
            new_delta.append(S)
        else:
            j = l - N_A
            mix = mixer_b(xn, q_pos, k_all, v_all, k_pos, W['w_in_b'][j], W['lambda_qk'][j], W['subln_b'][j],
                          lambda_init(l), W['rel_bias'], mem_k[l], mem_v[l], blocked)
        h = h + rmsnorm(mix @ W['w_out'][l], ng[3])
        h = h + 0.5 * rmsnorm(swiglu(rmsnorm(h, ng[4]), W['ffn_gate_up'][l, 1], W['ffn_down'][l, 1]), ng[5])
    return h, jnp.stack(new_conv), jnp.stack(new_delta), k_new, v_new


def setup_inputs(seed: int = 0) -> dict:
    key = jax.random.key(seed)
    ks = jax.random.split(key, 32)

    def nrm(k, shape, scale=1.0):
        return jax.random.normal(k, shape, jnp.float32) * scale

    dt = jnp.exp(jax.random.uniform(ks[18], (N_A, GDN_HEADS), jnp.float32, math.log(1e-3), math.log(0.1)))
    return {
        'x_prompt': nrm(ks[0], (BATCH, SEQ, D_MODEL)),
        'x_sample': nrm(ks[1], (DEC_BATCH, DEC_SEQ, D_MODEL)),
        'mem_prompt': nrm(ks[2], (BATCH, MEM_LEN, D_MODEL)),
        'cache_k': nrm(ks[3], (DEC_BATCH, PAST_LEN, DIFF_HEADS, 2, DIFF_DK)),
        'cache_v': nrm(ks[4], (DEC_BATCH, PAST_LEN, DIFF_HEADS, DIFF_DV)),
        'cache_mem_k': nrm(ks[5], (DEPTH, DEC_BATCH, MEM_LEN, MEM_HEADS, HEAD_DIM)),
        'cache_mem_v': nrm(ks[6], (DEPTH, DEC_BATCH, MEM_LEN, MEM_HEADS, HEAD_DIM)),
        'state_delta': nrm(ks[7], (N_A, DEC_BATCH, GDN_HEADS, HEAD_DIM, HEAD_DIM), 0.1),
        'state_conv': nrm(ks[8], (N_A, DEC_BATCH, CONV_WIDTH - 1, CONV_DIM)),
        'norm_gains': 1.0 + nrm(ks[9], (DEPTH, 6, D_MODEL), 0.02),
        'ffn_gate_up': nrm(ks[10], (DEPTH, 2, D_MODEL, 2 * D_FF), D_MODEL ** -0.5),
        'ffn_down': nrm(ks[11], (DEPTH, 2, D_FF, D_MODEL), D_FF ** -0.5),
        'w_out': nrm(ks[12], (DEPTH, D_MODEL, D_MODEL), D_MODEL ** -0.5),
        'mem_norm': 1.0 + nrm(ks[13], (DEPTH, D_MODEL), 0.02),
        'w_mem_kv': nrm(ks[14], (DEPTH, D_MODEL, 2 * MEM_WIDTH), D_MODEL ** -0.5),
        'w_in_a': nrm(ks[15], (N_A, D_MODEL, IN_A), D_MODEL ** -0.5),
        'conv_w_a': nrm(ks[16], (N_A, CONV_WIDTH, CONV_DIM), CONV_WIDTH ** -0.5),
        'a_log': jnp.log(jax.random.uniform(ks[17], (N_A, GDN_HEADS), jnp.float32, 1.0, 16.0)),
        'dt_bias': dt + jnp.log(-jnp.expm1(-dt)),
        'onorm_a': 1.0 + nrm(ks[19], (N_A, HEAD_DIM), 0.02),
        'kv_norm': 1.0 + nrm(ks[20], (D_MODEL,), 0.02),
        'w_kv': nrm(ks[21], (D_MODEL, KV_B), D_MODEL ** -0.5),
        'w_in_b': nrm(ks[22], (N_B, D_MODEL, IN_B), D_MODEL ** -0.5),
        'lambda_qk': nrm(ks[23], (N_B, 4, DIFF_DK), 0.1),
        'subln_b': 1.0 + nrm(ks[24], (N_B, DIFF_DV), 0.02),
        'rel_bias': nrm(ks[25], (N_BUCKETS, DIFF_HEADS), 0.5),
    }


def reference(x_prompt, x_sample, mem_prompt, cache_k, cache_v, cache_mem_k, cache_mem_v, state_delta,
              state_conv, norm_gains, ffn_gate_up, ffn_down, w_out, mem_norm, w_mem_kv, w_in_a, conv_w_a,
              a_log, dt_bias, onorm_a, kv_norm, w_kv, w_in_b, lambda_qk, subln_b, rel_bias):
    W = {'norm_gains': norm_gains, 'ffn_gate_up': ffn_gate_up, 'ffn_down': ffn_down, 'w_out': w_out,
         'w_in_a': w_in_a, 'conv_w_a': conv_w_a, 'a_log': a_log, 'dt_bias': dt_bias, 'onorm_a': onorm_a,
         'kv_norm': kv_norm, 'w_kv': w_kv, 'w_in_b': w_in_b, 'lambda_qk': lambda_qk, 'subln_b': subln_b,
         'rel_bias': rel_bias}
    mem_kv_p = [memory_kv(mem_prompt, mem_norm[l], w_mem_kv[l]) for l in range(DEPTH)]
    mem_k_p = jnp.stack([kv[0] for kv in mem_kv_p])
    mem_v_p = jnp.stack([kv[1] for kv in mem_kv_p])
    bp = x_prompt.shape[0]
    conv0 = jnp.zeros((N_A, bp, CONV_WIDTH - 1, CONV_DIM), x_prompt.dtype)
    delta0 = jnp.zeros((N_A, bp, GDN_HEADS, HEAD_DIM, HEAD_DIM), x_prompt.dtype)
    y_prompt, conv_p, delta_p, k_p, v_p = run_group(
        x_prompt, jnp.arange(x_prompt.shape[1]), mem_k_p, mem_v_p, conv0, delta0, None, None, True, W)
    q_pos_s = cache_k.shape[1] + jnp.arange(x_sample.shape[1])
    y_sample, conv_s, delta_s, k_s, v_s = run_group(
        x_sample, q_pos_s, cache_mem_k, cache_mem_v, state_conv, state_delta, cache_k, cache_v, False, W)
    return (y_prompt, y_sample, delta_p, conv_p, k_p, v_p, mem_k_p, mem_v_p, delta_s, conv_s, k_s, v_s)
```

```cpp
#define REPMASK 0
#include <hip/hip_runtime.h>
#include <hip/hip_cooperative_groups.h>
#include <cstdio>
namespace cg = cooperative_groups;
namespace pg8 {
#define PG8_LAS __attribute__((address_space(3)))
typedef unsigned short bf16_t;
typedef short bf16x8 __attribute__((ext_vector_type(8)));
typedef float f32x4 __attribute__((ext_vector_type(4)));
typedef unsigned u32x4 __attribute__((ext_vector_type(4)));
constexpr int BM = 256, BK = 64, HALF = 128, HTB = HALF * BK * 2  , STAGE_BYTES = 8 * HTB, NXCD = 8, WGM = 8;

__host__ __device__ __forceinline__ int lds_byte(int r, int c) { const int st = (r >> 4) * 2 + (c >> 5), rr = r & 15, cc = c & 31, ob = rr * 64 + cc * 2; return st * 1024 + (ob ^ (((ob >> 9) & 1) << 5)); }
__host__ __device__ __forceinline__ void stage_rc(int b, int& R, int& C) { const int st = b / 1024, sb = b % 1024, swz = sb ^ (((sb >> 9) & 1) << 5); R = (st >> 1) * 16 + swz / 64; C = (st & 1) * 32 + (swz % 64) / 2; }
__host__ __device__ __forceinline__ int perm32(int rho) { const int n = rho >> 4, i = rho & 15; return 8 * (i >> 2) + 4 * n + (i & 3); }

struct Unit { int pm, pn; };
struct Gemm { const bf16_t* A; const bf16_t* Bt; int M, N, K; int ld, mt, ksl; };

struct StaticOrder {
    int nM, nN, nwg, G, c;
    __host__ __device__ void init(int M, int N, int G_, int c_) { nM = M / BM; nN = N / BM; nwg = nM * nN; G = G_; c = c_; }
    __host__ __device__ bool next(int i, Unit& u) const {
        const long L = (long)i * G + c; if (L >= nwg) return false;
        int wgid = (int)L; { const int q = nwg / NXCD, r = nwg % NXCD, xcd = wgid % NXCD, off = wgid / NXCD; wgid = (xcd < r ? xcd * (q + 1) : r * (q + 1) + (xcd - r) * q) + off; }
        const int nig = WGM * nN, gid = wgid / nig, fm = gid * WGM, gsz = (nM - fm) < WGM ? (nM - fm) : WGM;
        u.pm = fm + ((wgid % nig) % gsz); u.pn = (wgid % nig) / gsz; return true;
    }
    __device__ __forceinline__ void a_ready(const Unit&) const {}
    __device__ __forceinline__ void done(const Unit&) const {}
};
__device__ __forceinline__ unsigned cvt_pk_bf16(float lo, float hi) { unsigned r; asm volatile("v_cvt_pk_bf16_f32 %0, %1, %2" : "=v"(r) : "v"(lo), "v"(hi)); return r; }
typedef float f32x2 __attribute__((ext_vector_type(2)));
template <class Epi, class Sched, bool ALIGN_EPI = false, bool SP2 = false>
__device__ __forceinline__ void gemm_phase(PG8_LAS unsigned char* lds, const Gemm g, const Sched& S, const Epi& E, int tid_in) {
    int tid_ = tid_in; asm volatile("" : "+v"(tid_));
    const int tid = tid_, wid = __builtin_amdgcn_readfirstlane(tid >> 6), lane = tid & 63, wr = wid >> 2, wc = wid & 3, fr = lane & 15, fq = lane >> 4;
    const int K = g.ld, nt = g.K / BK;
    unsigned voffA[2], voffB[2];
#pragma unroll
    for (int i = 0; i < 2; ++i) { int R, C; stage_rc(tid * 16 + i * 8192, R, C); const int Rb = Epi::PERM ? ((R & ~31) + perm32(R & 31)) : R;
        voffA[i] = (unsigned)(R * K + C) * 2u; voffB[i] = (unsigned)(Rb * K + C) * 2u; }
    const size_t kstep = (size_t)(BK * 2);
    const size_t hstep = (size_t)HALF * K * 2;
    const size_t tstep = 2 * hstep;
    const unsigned ldsw = (unsigned)wid * 1024u;
    const int aoff = lds_byte(wr * 64 + fr, fq * 8), boff = lds_byte(wc * 32 + fr, fq * 8);
#define PG8_SA(b, h) (((b) * 2 + (h)) * HTB)
#define PG8_SB(b, h) ((4 + (b) * 2 + (h)) * HTB)
#define PG8_STAGE(bufoff, gbase, voff) do { _Pragma("unroll") for (int _i = 0; _i < 2; ++_i) \
        __builtin_amdgcn_global_load_lds((const unsigned*)((const char*)(gbase) + (voff)[_i]), (PG8_LAS unsigned*)(lds + (bufoff) + ldsw + _i * 8192), 16, 0, 0); } while (0)
#define PG8_LDA(dst, b, h) do { _Pragma("unroll") for (int m = 0; m < 4; ++m) _Pragma("unroll") for (int k = 0; k < 2; ++k) dst[m][k] = *(const PG8_LAS bf16x8*)(lds + PG8_SA(b, h) + aoff + m * 2048 + k * 1024); } while (0)
#define PG8_LDB(dst, b, h) do { _Pragma("unroll") for (int n = 0; n < 2; ++n) _Pragma("unroll") for (int k = 0; k < 2; ++k) dst[n][k] = *(const PG8_LAS bf16x8*)(lds + PG8_SB(b, h) + boff + n * 2048 + k * 1024); } while (0)
#define PG8_MMA(ai, bj, At, Bt) do { __builtin_amdgcn_s_setprio(1); _Pragma("unroll") for (int m = 0; m < 4; ++m) _Pragma("unroll") for (int n = 0; n < 2; ++n) _Pragma("unroll") for (int k = 0; k < 2; ++k) \
        acc[ai][bj][m][n] = __builtin_amdgcn_mfma_f32_16x16x32_bf16(Bt[n][k], At[m][k], acc[ai][bj][m][n], 0, 0, 0); __builtin_amdgcn_s_setprio(0); } while (0)
#define PG8_WAIT_V(n) asm volatile("s_waitcnt vmcnt(" #n ")" ::: "memory")
#define PG8_WAIT_L(n) asm volatile("s_waitcnt lgkmcnt(" #n ")" ::: "memory")
#define PG8_BAR __builtin_amdgcn_s_barrier()
#define PG8_SCHED __builtin_amdgcn_sched_barrier(0)
    Unit cur, nxt; int ui = 0;
    if (!S.next(0, cur)) return;
    f32x4 acc[2][2][4][2];
#pragma unroll
    for (int a = 0; a < 2; ++a)
#pragma unroll
        for (int b = 0; b < 2; ++b)
#pragma unroll
            for (int m = 0; m < 4; ++m)
#pragma unroll
                for (int n = 0; n < 2; ++n) acc[a][b][m][n] = (f32x4){0.f, 0.f, 0.f, 0.f};
    bf16x8 At[4][2], B0[2][2], B1[2][2];
#define PG8_UA(u) ((const char*)g.A + (size_t)((u).pm % g.mt) * tstep + (size_t)((u).pm / g.mt) * (size_t)g.ksl * 2)
#define PG8_UB(u) ((const char*)g.Bt + (size_t)(u).pn * tstep + (size_t)((u).pm / g.mt) * (size_t)g.ksl * 2)
    const char* cA = PG8_UA(cur); const char* cB = PG8_UB(cur);
    S.a_ready(cur);
    if constexpr (SP2) {
        PG8_STAGE(PG8_SB(0, 0), cB, voffB); PG8_STAGE(PG8_SB(0, 1), cB + hstep, voffB); PG8_STAGE(PG8_SA(0, 0), cA, voffA); PG8_STAGE(PG8_SA(0, 1), cA + hstep, voffA);
        if (wr == 1) PG8_BAR;
        PG8_WAIT_V(2); PG8_BAR;
        PG8_STAGE(PG8_SB(1, 0), cB + kstep, voffB); PG8_STAGE(PG8_SA(1, 0), cA + kstep, voffA); PG8_STAGE(PG8_SB(1, 1), cB + hstep + kstep, voffB);
        PG8_WAIT_V(6); PG8_BAR;
    } else {
        PG8_STAGE(PG8_SB(0, 0), cB, voffB); PG8_STAGE(PG8_SA(0, 0), cA, voffA); PG8_STAGE(PG8_SB(0, 1), cB + hstep, voffB); PG8_STAGE(PG8_SA(0, 1), cA + hstep, voffA);
        if (wr == 1) PG8_BAR;
        PG8_WAIT_V(4); PG8_BAR;
        PG8_STAGE(PG8_SB(1, 0), cB + kstep, voffB); PG8_STAGE(PG8_SA(1, 0), cA + kstep, voffA); PG8_STAGE(PG8_SB(1, 1), cB + hstep + kstep, voffB);
        PG8_WAIT_V(6); PG8_BAR;
    }
    for (;;) {
        const bool has_next = S.next(ui + 1, nxt);
        const char* nA = has_next ? PG8_UA(nxt) : cA; const char* nB = has_next ? PG8_UB(nxt) : cB;
        for (int t = 0; t < nt; t += 2) {
            const bool last = (t == nt - 2);
            const char* a1 = cA + (size_t)(t + 1) * kstep;
            const char* a2 = last ? nA : cA + (size_t)(t + 2) * kstep; const char* b2 = last ? nB : cB + (size_t)(t + 2) * kstep;
            const char* a3 = a2 + kstep; const char* b3 = b2 + kstep;
            if (last && has_next) S.a_ready(nxt);
            if constexpr (SP2) {
            PG8_LDB(B0, 0, 0); PG8_LDB(B1, 0, 1); PG8_SCHED; PG8_LDA(At, 0, 0); PG8_STAGE(PG8_SA(1, 1), a1 + hstep, voffA);
            PG8_WAIT_V(8); PG8_WAIT_L(0); PG8_BAR; PG8_MMA(0, 0, At, B0); PG8_MMA(0, 1, At, B1); PG8_BAR; PG8_SCHED;
            PG8_LDA(At, 0, 1); PG8_STAGE(PG8_SB(0, 0), b2, voffB); PG8_STAGE(PG8_SB(0, 1), b2 + hstep, voffB); PG8_STAGE(PG8_SA(0, 0), a2, voffA);
            PG8_WAIT_V(8); PG8_WAIT_L(0); PG8_BAR; PG8_MMA(1, 0, At, B0); PG8_MMA(1, 1, At, B1); PG8_BAR; PG8_SCHED;
            PG8_LDB(B0, 1, 0); PG8_LDB(B1, 1, 1); PG8_SCHED; PG8_LDA(At, 1, 0); PG8_STAGE(PG8_SA(0, 1), a2 + hstep, voffA);
            PG8_WAIT_V(8); PG8_WAIT_L(0); PG8_BAR; PG8_MMA(0, 0, At, B0); PG8_MMA(0, 1, At, B1); PG8_BAR; PG8_SCHED;
            PG8_LDA(At, 1, 1); PG8_STAGE(PG8_SB(1, 0), b3, voffB); PG8_STAGE(PG8_SB(1, 1), b3 + hstep, voffB); PG8_STAGE(PG8_SA(1, 0), a3, voffA);
            PG8_WAIT_V(8); PG8_WAIT_L(0); PG8_BAR; PG8_MMA(1, 0, At, B0); PG8_MMA(1, 1, At, B1); PG8_BAR; PG8_SCHED;
            } else {
            PG8_LDB(B0, 0, 0); PG8_SCHED; PG8_LDA(At, 0, 0); PG8_STAGE(PG8_SA(1, 1), a1 + hstep, voffA);
            PG8_WAIT_L(8); PG8_BAR; PG8_WAIT_L(0); PG8_MMA(0, 0, At, B0); PG8_BAR; PG8_SCHED;
            PG8_LDB(B1, 0, 1); PG8_STAGE(PG8_SB(0, 0), b2, voffB);
            PG8_BAR; PG8_WAIT_L(0); PG8_MMA(0, 1, At, B1); PG8_BAR;
            PG8_LDA(At, 0, 1); PG8_STAGE(PG8_SA(0, 0), a2, voffA);
            PG8_BAR; PG8_WAIT_L(0); PG8_MMA(1, 0, At, B0); PG8_BAR; PG8_SCHED;
            PG8_STAGE(PG8_SB(0, 1), b2 + hstep, voffB);
            PG8_WAIT_V(6); PG8_BAR; PG8_MMA(1, 1, At, B1); PG8_BAR;
            PG8_LDB(B0, 1, 0); PG8_SCHED; PG8_LDA(At, 1, 0); PG8_STAGE(PG8_SA(0, 1), a2 + hstep, voffA);
            PG8_WAIT_L(8); PG8_BAR; PG8_WAIT_L(0); PG8_MMA(0, 0, At, B0); PG8_BAR; PG8_SCHED;
            PG8_LDB(B1, 1, 1); PG8_STAGE(PG8_SB(1, 0), b3, voffB);
            PG8_BAR; PG8_WAIT_L(0); PG8_MMA(0, 1, At, B1); PG8_BAR;
            PG8_LDA(At, 1, 1); PG8_STAGE(PG8_SA(1, 0), a3, voffA);
            PG8_BAR; PG8_WAIT_L(0); PG8_MMA(1, 0, At, B0); PG8_BAR; PG8_SCHED;
            PG8_STAGE(PG8_SB(1, 1), b3 + hstep, voffB);
            PG8_WAIT_V(6); PG8_BAR; PG8_MMA(1, 1, At, B1); PG8_BAR;
            }
        }
        if constexpr (ALIGN_EPI) { if (wr == 0) PG8_BAR; }
        if constexpr (!Epi::AFTER_DRAIN) { E(acc, cur, wr, wc, fr, fq); S.done(cur); }
        if (!has_next) break;
#pragma unroll
        for (int a = 0; a < 2; ++a)
#pragma unroll
            for (int b = 0; b < 2; ++b)
#pragma unroll
                for (int m = 0; m < 4; ++m)
#pragma unroll
                    for (int n = 0; n < 2; ++n) acc[a][b][m][n] = (f32x4){0.f, 0.f, 0.f, 0.f};
        cur = nxt; cA = nA; cB = nB; ++ui;
        if constexpr (ALIGN_EPI) { if (wr == 1) PG8_BAR; }
    }
    PG8_WAIT_V(0);
    if constexpr (!ALIGN_EPI) { if (wr == 0) PG8_BAR; }
    PG8_BAR;
    if constexpr (Epi::AFTER_DRAIN) { E.fused(acc, cur, wr, wc, fr, fq, lds, wid, lane); S.done(cur); }
#undef PG8_SA
#undef PG8_SB
#undef PG8_STAGE
#undef PG8_LDA
#undef PG8_LDB
#undef PG8_MMA
#undef PG8_WAIT_V
#undef PG8_WAIT_L
#undef PG8_BAR
#undef PG8_SCHED
}
}


using pg8::bf16_t; using pg8::bf16x8; using pg8::f32x4; using pg8::u32x4;
typedef unsigned u32x2 __attribute__((ext_vector_type(2)));
typedef short bf16x4 __attribute__((ext_vector_type(4)));
#define LAS PG8_LAS

constexpr int NT = 512;
constexpr int MP = 16384, MS = 512, MT = MP + MS;
constexpr int DM = 2048, FF = 5632, NGU = 2 * FF;
constexpr int INA = 6680, INA_P = 6912, LOGC = 6144, QMA = 6168;
constexpr int NKV = 3072, INB = 2048;
constexpr int NITEM = 264 * 12;
constexpr float EPSF = 1e-6f;
constexpr float LOG2E = 1.4426950408889634f;
constexpr float LAM0 = 0.35550906759f;

constexpr size_t O_Y = 0;
constexpr size_t O_DELTA_P = (size_t)MT * DM;
constexpr size_t O_CONV_P = O_DELTA_P + 12 * 128 * 128;
constexpr size_t O_K_P = O_CONV_P + 3 * 4608;
constexpr size_t O_V_P = O_K_P + (size_t)MP * 1536;
constexpr size_t O_MK_P = O_V_P + (size_t)MP * 1536;
constexpr size_t O_MV_P = O_MK_P + 2 * 256 * 512;
constexpr size_t O_DELTA_S = O_MV_P + 2 * 256 * 512;
constexpr size_t O_CONV_S = O_DELTA_S + 8 * 12 * 128 * 128;
constexpr size_t O_K_S = O_CONV_S + 8 * 3 * 4608;
constexpr size_t O_V_S = O_K_S + (size_t)MS * 1536;

constexpr size_t AL(size_t x) { return (x + 4095) & ~(size_t)4095; }
constexpr size_t SZ_WGU = (size_t)NGU * DM * 2, SZ_WDN = (size_t)DM * FF * 2, SZ_WSQ = (size_t)DM * DM * 2;
constexpr size_t W_GU = 0;
constexpr size_t W_DN = W_GU + 4 * SZ_WGU;
constexpr size_t W_INA = W_DN + 4 * SZ_WDN;
constexpr size_t W_OUT = W_INA + (size_t)INA_P * DM * 2;
constexpr size_t W_KV = W_OUT + 2 * SZ_WSQ;
constexpr size_t W_INB = W_KV + (size_t)NKV * DM * 2;
constexpr size_t W_MEM = W_INB + SZ_WSQ;
constexpr size_t B_XN = W_MEM + 2 * (size_t)1024 * DM * 2;
constexpr size_t B_MIX = B_XN + (size_t)MT * DM * 2;
constexpr size_t B_R1 = B_MIX + (size_t)MT * DM * 2;
constexpr size_t SZ_R = (size_t)MT * INA_P * 2;
constexpr size_t B_R2 = B_R1 + SZ_R;
constexpr size_t B_O = B_R2 + SZ_R;
constexpr size_t B_LOG = B_O + (size_t)MT * 1536 * 4;
constexpr size_t B_GL = B_LOG + AL((size_t)MT * 24 * 4);
constexpr size_t B_KP = B_GL + AL((size_t)NITEM * 4);
constexpr size_t B_VTP = B_KP + (size_t)MP * 1536 * 2;
constexpr size_t B_KS = B_VTP + (size_t)MP * 1536 * 2;
constexpr size_t B_VTS = B_KS + (size_t)8 * 1088 * 1536 * 2;
constexpr size_t B_MEMN = B_VTS + (size_t)8 * 1088 * 1536 * 2;
constexpr size_t B_MK = B_MEMN + (size_t)2 * 256 * DM * 2;
constexpr size_t B_MVT = B_MK + (size_t)2 * 9 * 4 * 256 * 128 * 2;
constexpr size_t B_DP = B_MVT + (size_t)2 * 9 * 4 * 256 * 128 * 2;
constexpr size_t B_BAR = B_DP + (size_t)11 * 512 * DM * 4;
constexpr size_t WS_END = B_BAR + 16384;
constexpr size_t G_UT = 0, G_W = (size_t)NITEM * 8192, G_QG = 2 * G_W, G_KDT = 3 * G_W, G_A = 4 * G_W;

constexpr int LDS_BYTES = 147456;

struct Args { const float* in[26]; float* out; unsigned char* ws; int ph_lo, ph_hi, repmask, pad; };

__device__ __forceinline__ unsigned pk2(float lo, float hi) { unsigned r; asm volatile("v_cvt_pk_bf16_f32 %0, %1, %2" : "=v"(r) : "v"(lo), "v"(hi)); return r; }
__device__ __forceinline__ bf16_t f2bf(float f) { return (bf16_t)(pk2(f, 0.f) & 0xffffu); }
__device__ __forceinline__ float bf2f(bf16_t b) { return __uint_as_float(((unsigned)b) << 16); }
__device__ __forceinline__ float shx(float v, int mask, int lane) { return __int_as_float(__builtin_amdgcn_ds_bpermute((lane ^ mask) << 2, __float_as_int(v))); }
__device__ __forceinline__ float wave_sum(float v, int lane) {
#pragma unroll
    for (int o = 1; o < 64; o <<= 1) v += shx(v, o, lane);
    return v;
}
__device__ __forceinline__ float siluf(float x) { return x * __builtin_amdgcn_rcpf(1.f + __expf(-x)); }
__device__ __forceinline__ const float* xrow(const Args& a, int r) { return r < MP ? a.in[0] + (size_t)r * DM : a.in[1] + (size_t)(r - MP) * DM; }

struct EpiBase { int mode; float* f0; float* f1; bf16_t* b0; bf16_t* b1; int ldc; };
struct EpiF32G : EpiBase {
    static constexpr bool PERM = true, AFTER_DRAIN = false;
    __device__ __forceinline__ void operator()(const f32x4 (&acc)[2][2][4][2], const pg8::Unit& u, int wr, int wc, int fr, int fq) const {
        const int rl = wr * 64 + fr, cl = wc * 32 + 8 * fq;
        float* C; int ld;
        if (mode == 0) { C = f0 + (size_t)u.pm * 256 * ldc + u.pn * 256; ld = ldc; }
        else if (mode == 3) { const bool isv = u.pn >= 6, pr = u.pm < 64; ld = 1536;
            C = f0 + (pr ? (isv ? O_V_P : O_K_P) + (size_t)u.pm * 256 * 1536 : (isv ? O_V_S : O_K_S) + (size_t)(u.pm - 64) * 256 * 1536) + (isv ? u.pn - 6 : u.pn) * 256; }
        else { ld = 512; C = u.pn < 2 ? f0 + u.pn * 256 : f1 + (u.pn - 2) * 256; }
#pragma unroll
        for (int ai = 0; ai < 2; ++ai)
#pragma unroll
            for (int m = 0; m < 4; ++m) { float* rowp = C + (size_t)(rl + ai * 128 + m * 16) * ld + cl;
#pragma unroll
                for (int bj = 0; bj < 2; ++bj)
#pragma unroll
                    for (int n = 0; n < 2; ++n) *(f32x4*)(rowp + bj * 128 + n * 4) = acc[ai][bj][m][n]; }
    }
};
struct EpiSwigluG : EpiBase {
    static constexpr bool PERM = true, AFTER_DRAIN = false;
    __device__ __forceinline__ void operator()(const f32x4 (&acc)[2][2][4][2], const pg8::Unit& u, int wr, int wc, int fr, int fq) const {
        const int rl = wr * 64 + fr, cl = wc * 32 + 8 * fq;
        bf16_t* O = b0 + (size_t)u.pm * 256 * FF + u.pn * 128;
#pragma unroll
        for (int ai = 0; ai < 2; ++ai)
#pragma unroll
            for (int m = 0; m < 4; ++m) {
                float v[8];
#pragma unroll
                for (int n = 0; n < 2; ++n)
#pragma unroll
                    for (int j = 0; j < 4; ++j) { const float g = acc[ai][0][m][n][j], up = acc[ai][1][m][n][j]; v[n * 4 + j] = g * up * __builtin_amdgcn_rcpf(1.f + __expf(-g)); }
                u32x4 w; w.x = pk2(v[0], v[1]); w.y = pk2(v[2], v[3]); w.z = pk2(v[4], v[5]); w.w = pk2(v[6], v[7]);
                *(u32x4*)(O + (size_t)(rl + ai * 128 + m * 16) * FF + cl) = w; }
    }
};
struct EpiBf16G : EpiBase {
    static constexpr bool PERM = true, AFTER_DRAIN = false;
    __device__ __forceinline__ void operator()(const f32x4 (&acc)[2][2][4][2], const pg8::Unit& u, int wr, int wc, int fr, int fq) const {
        const int rl = wr * 64 + fr, cl = wc * 32 + 8 * fq;
        bf16_t* O = b0 + (size_t)u.pm * 256 * ldc + u.pn * 256;
#pragma unroll
        for (int ai = 0; ai < 2; ++ai)
#pragma unroll
            for (int m = 0; m < 4; ++m) { const int r = rl + ai * 128 + m * 16;
#pragma unroll
                for (int bj = 0; bj < 2; ++bj) { const f32x4 v0 = acc[ai][bj][m][0], v1 = acc[ai][bj][m][1]; const int c = cl + bj * 128;
                    u32x4 w; w.x = pk2(v0[0], v0[1]); w.y = pk2(v0[2], v0[3]); w.z = pk2(v1[0], v1[1]); w.w = pk2(v1[2], v1[3]);
                    *(u32x4*)(O + (size_t)r * ldc + c) = w;
                    const int cg = u.pn * 256 + c;
                    if (f0 && cg >= LOGC && cg < LOGC + 24) { float* lp = f0 + (size_t)(u.pm * 256 + r) * 24 + (cg - LOGC); *(f32x4*)lp = v0; *(f32x4*)(lp + 4) = v1; } } }
    }
};

template <int MODE>
__device__ __forceinline__ void conv_weight(const float* W, int K, int N, int NP, bf16_t* WT, float* scr, int gw, int ngw, int lane, int ldd = 0) {
    if (ldd == 0) ldd = K;
    const int nblk = NP / 32, nitems = (K / 64) * nblk;
    for (int it = gw; it < nitems; it += ngw) {
        const int kb = it / nblk, nb = it % nblk, k0 = 64 * kb, n0 = 32 * nb;
        const int n = n0 + (lane & 31); const bool ok = n < N;
        float wv[32];
#pragma unroll
        for (int i = 0; i < 32; ++i) wv[i] = ok ? W[(size_t)(k0 + 2 * i + (lane >> 5)) * N + n] : 0.f;
#pragma unroll
        for (int i = 0; i < 32; ++i) scr[(2 * i + (lane >> 5)) * 33 + (lane & 31)] = wv[i];
        asm volatile("s_waitcnt lgkmcnt(0)" ::: "memory");
        int drow0 = n0;
        if (MODE == 1) { const int half = n0 >= FF ? 1 : 0, j = n0 - half * FF; drow0 = 256 * (j >> 7) + 128 * half + (j & 127); }
        const int c = lane & 7;
#pragma unroll
        for (int j = 0; j < 4; ++j) { const int nn = (lane >> 3) + 8 * j; const float* s = scr + (8 * c) * 33 + nn;
            u32x4 o; o.x = pk2(s[0], s[33]); o.y = pk2(s[2 * 33], s[3 * 33]); o.z = pk2(s[4 * 33], s[5 * 33]); o.w = pk2(s[6 * 33], s[7 * 33]);
            *(u32x4*)(WT + (size_t)(drow0 + nn) * ldd + k0 + 8 * c) = o; }
        asm volatile("s_waitcnt lgkmcnt(0)" ::: "memory");
    }
}

__device__ __forceinline__ void row_update(const float* hin, float* hout, const float* d, float coef, const float* g1, const float* g2, bf16_t* xn, const float* g3, bf16_t* kvn, int lane, int nd = 1, size_t dstride = 0, const bf16_t* dbf = nullptr) {
    f32x4 h[8];
#pragma unroll
    for (int j = 0; j < 8; ++j) h[j] = *(const f32x4*)(hin + 4 * (lane + 64 * j));
    if (d || dbf) {
        f32x4 dv[8]; float ss = 0.f;
        if (dbf) {
#pragma unroll
            for (int j = 0; j < 8; ++j) { const u32x2 w = *(const u32x2*)(dbf + 4 * (lane + 64 * j)); dv[j] = (f32x4){__uint_as_float(w.x << 16), __uint_as_float(w.x & 0xffff0000u), __uint_as_float(w.y << 16), __uint_as_float(w.y & 0xffff0000u)}; }
        } else {
#pragma unroll
            for (int j = 0; j < 8; ++j) dv[j] = *(const f32x4*)(d + 4 * (lane + 64 * j));
        }
        for (int s = 1; s < nd; ++s) {
#pragma unroll
            for (int j = 0; j < 8; ++j) dv[j] += *(const f32x4*)(d + (size_t)s * dstride + 4 * (lane + 64 * j)); }
#pragma unroll
        for (int j = 0; j < 8; ++j) { ss += (dv[j].x * dv[j].x + dv[j].y * dv[j].y) + (dv[j].z * dv[j].z + dv[j].w * dv[j].w); }
        const float rs = coef * rsqrtf(wave_sum(ss, lane) * (1.f / DM) + EPSF);
#pragma unroll
        for (int j = 0; j < 8; ++j) { const f32x4 g = *(const f32x4*)(g1 + 4 * (lane + 64 * j)); h[j] += dv[j] * g * rs; }
    }
    if (hout) {
#pragma unroll
        for (int j = 0; j < 8; ++j) *(f32x4*)(hout + 4 * (lane + 64 * j)) = h[j];
    }
    if (g2) {
        float ss = 0.f;
#pragma unroll
        for (int j = 0; j < 8; ++j) ss += (h[j].x * h[j].x + h[j].y * h[j].y) + (h[j].z * h[j].z + h[j].w * h[j].w);
        const float rs = rsqrtf(wave_sum(ss, lane) * (1.f / DM) + EPSF);
#pragma unroll
        for (int j = 0; j < 8; ++j) { const f32x4 g = *(const f32x4*)(g2 + 4 * (lane + 64 * j)); const f32x4 o = h[j] * g * rs;
            u32x2 w; w.x = pk2(o.x, o.y); w.y = pk2(o.z, o.w); *(u32x2*)(xn + 4 * (lane + 64 * j)) = w; }
        if (g3) {
#pragma unroll
            for (int j = 0; j < 8; ++j) { const f32x4 g = *(const f32x4*)(g3 + 4 * (lane + 64 * j)); const f32x4 o = h[j] * g * rs;
                u32x2 w; w.x = pk2(o.x, o.y); w.y = pk2(o.z, o.w); *(u32x2*)(kvn + 4 * (lane + 64 * j)) = w; }
        }
    }
}

__device__ __forceinline__ void phase_rowpass(const Args& a, const float* D, float coef, const float* g1, const float* g2, const float* g3, int gw, int ngw, int lane, int ks) {
    float* H = a.out; bf16_t* XN = (bf16_t*)(a.ws + B_XN); bf16_t* KVN = (bf16_t*)(a.ws + B_MIX); const float* DP = (const float*)(a.ws + B_DP);
    for (int r = gw; r < MT; r += ngw) {
        if (r < MP) row_update(H + (size_t)r * DM, H + (size_t)r * DM, nullptr, coef, g1, g2, XN + (size_t)r * DM, g3, KVN + (size_t)r * DM, lane, 1, 0, (const bf16_t*)D + (size_t)r * DM);
        else row_update(H + (size_t)r * DM, H + (size_t)r * DM, DP + (size_t)(r - MP) * DM, coef, g1, g2, XN + (size_t)r * DM, g3, KVN + (size_t)r * DM, lane, ks, (size_t)512 * DM);
    }
}

constexpr int GP_ROW = 136;
constexpr int GP_L = 0;
constexpr int GP_SC = 64 * 68 * 4;
constexpr int GP_TS = 64 * GP_ROW * 2;
constexpr int GP_QH = GP_SC + 4096, GP_QL = GP_QH + GP_TS, GP_KH = GP_QL + GP_TS, GP_KL = GP_KH + GP_TS;
__device__ __forceinline__ void gdn_prep_item(unsigned char* lds, const Args& a, int cidx, int h, int tid_in) {
    int tid_ = tid_in; asm volatile("" : "+v"(tid_));
    const int tid = tid_, lane = tid & 63, wid = tid >> 6;
    const bf16_t* PROJ = (const bf16_t*)(a.ws + B_R1);
    const float* LOG = (const float*)(a.ws + B_LOG);
    bf16_t* GI = (bf16_t*)(a.ws + B_R2);
    const int item = cidx * 12 + h;
    const int row0 = cidx < 256 ? cidx * 64 : MP + (cidx - 256) * 64;
    unsigned sb_ = GP_SC; asm volatile("" : "+v"(sb_));
    float* sc = (float*)(lds + sb_);
    float* sBeta = sc, *sGc = sc + 64, *sEg = sc + 128, *sEd = sc + 192, *sPart = sc + 256;
    float v[64];
#pragma unroll
    for (int r = 0; r < 64; ++r) v[r] = 0.f;
    const int role = tid >> 7, c = tid & 127;
    if (tid < 384) {
        const int ch = role * 1536 + h * 128 + c;
        const float* cw = a.in[16];
        const float w0 = cw[ch], w1 = cw[4608 + ch], w2 = cw[2 * 4608 + ch], w3 = cw[3 * 4608 + ch];
        float x0, x1, x2;
        if (cidx >= 256) { const float* sb = a.in[8] + (size_t)(cidx - 256) * 3 * 4608 + ch; x0 = sb[0]; x1 = sb[4608]; x2 = sb[2 * 4608]; }
        else if (cidx == 0) { x0 = x1 = x2 = 0.f; }
        else { const bf16_t* pb = PROJ + (size_t)(row0 - 3) * INA_P + ch; x0 = bf2f(pb[0]); x1 = bf2f(pb[INA_P]); x2 = bf2f(pb[2 * INA_P]); }
        const bf16_t* px = PROJ + (size_t)row0 * INA_P + ch; unsigned poff = 0;
#pragma unroll
        for (int r = 0; r < 64; ++r) { v[r] = bf2f(*(const bf16_t*)((const char*)px + poff)); poff += INA_P * 2; asm volatile("" : "+v"(poff)); }
#pragma unroll
        for (int r = 63; r >= 0; --r) { const float xm1 = r >= 1 ? v[r >= 1 ? r - 1 : 0] : x2, xm2 = r >= 2 ? v[r >= 2 ? r - 2 : 0] : (r == 1 ? x2 : x1), xm3 = r >= 3 ? v[r >= 3 ? r - 3 : 0] : (r == 2 ? x2 : (r == 1 ? x1 : x0));
            v[r] = siluf(w0 * xm3 + w1 * xm2 + w2 * xm1 + w3 * v[r]); }
        if (role < 2) {
            float t[64];
#pragma unroll
            for (int r = 0; r < 64; ++r) t[r] = v[r] * v[r];
#define BFLY(N, M) do { const bool up = lane & (M); \
                _Pragma("unroll") for (int c0 = 0; c0 < (N); c0 += 16) { float snd_[16], rcv_[16]; \
                _Pragma("unroll") for (int i = 0; i < 16; ++i) if (c0 + i < (N)) { snd_[i] = up ? t[c0 + i] : t[c0 + i + (N)]; t[c0 + i] = up ? t[c0 + i + (N)] : t[c0 + i]; } \
                _Pragma("unroll") for (int i = 0; i < 16; ++i) if (c0 + i < (N)) rcv_[i] = shx(snd_[i], (M), lane); \
                _Pragma("unroll") for (int i = 0; i < 16; ++i) if (c0 + i < (N)) t[c0 + i] += rcv_[i]; } } while (0)
            BFLY(32, 32); BFLY(16, 16); BFLY(8, 8); BFLY(4, 4); BFLY(2, 2); BFLY(1, 1);
            sPart[(role * 2 + (wid & 1)) * 64 + lane] = t[0];
        }
    } else if (wid == 6) {
        const float bl = LOG[(size_t)(row0 + lane) * 24 + h], al = LOG[(size_t)(row0 + lane) * 24 + 12 + h];
        const float beta = 1.f / (1.f + __expf(-bl));
        const float xx = al + a.in[18][h];
        const float sp = xx > 20.f ? xx : __logf(1.f + __expf(xx));
        float g = -__expf(a.in[17][h]) * sp;
#pragma unroll
        for (int o = 1; o < 64; o <<= 1) { const float t = __int_as_float(__builtin_amdgcn_ds_bpermute((lane - o) << 2, __float_as_int(g))); if (lane >= o) g += t; }
        const float gl = __int_as_float(__builtin_amdgcn_readlane(__float_as_int(g), 63));
        sBeta[lane] = beta; sGc[lane] = g; sEg[lane] = __expf(g); sEd[lane] = __expf(gl - g);
        if (lane == 0) ((float*)(a.ws + B_GL))[item] = __expf(gl);
    }
    __syncthreads();
    if (wid == 7) {
        sc[512 + lane] = rsqrtf(sPart[lane] + sPart[64 + lane] + EPSF) * 0.08838834764831845f;
        sc[576 + lane] = rsqrtf(sPart[128 + lane] + sPart[192 + lane] + EPSF);
        sc[640 + lane] = sBeta[lane] * sEg[lane];
    }
    __syncthreads();
    if (tid < 384) {
        const f32x4* sc4 = (const f32x4*)sc;
        if (role == 0) {
            unsigned qh_ = GP_QH + c * 2; asm volatile("" : "+v"(qh_)); unsigned char* QH = lds + qh_; bf16_t* QG = GI + G_QG + (size_t)item * 8192 + c; unsigned qoff = 0;
#pragma unroll
            for (int hf = 0; hf < 2; ++hf) {
                f32x4 iq[8], eg[8];
#pragma unroll
                for (int g4 = 0; g4 < 8; ++g4) { iq[g4] = sc4[128 + hf * 8 + g4]; eg[g4] = sc4[32 + hf * 8 + g4]; }
                __builtin_amdgcn_sched_barrier(0);
#pragma unroll
                for (int rr = 0; rr < 32; ++rr) { const int r = hf * 32 + rr; const float q = v[r] * iq[rr >> 2][rr & 3];
                    const bf16_t hi = f2bf(q); *(bf16_t*)(QH + r * GP_ROW * 2) = hi; *(bf16_t*)(QH + GP_TS + r * GP_ROW * 2) = f2bf(q - bf2f(hi)); *(bf16_t*)((char*)QG + qoff) = f2bf(q * eg[rr >> 2][rr & 3]); qoff += 256; asm volatile("" : "+v"(qoff)); }
            }
        } else if (role == 1) {
            unsigned kh_ = GP_KH + c * 2; asm volatile("" : "+v"(kh_)); unsigned char* KH = lds + kh_; bf16_t* KDT = GI + G_KDT + (size_t)item * 8192 + (size_t)c * 64;
#pragma unroll
            for (int hf = 0; hf < 2; ++hf) {
                f32x4 ik[8], ed[8], be[8];
#pragma unroll
                for (int g4 = 0; g4 < 8; ++g4) { ik[g4] = sc4[144 + hf * 8 + g4]; ed[g4] = sc4[48 + hf * 8 + g4]; be[g4] = sc4[160 + hf * 8 + g4]; }
                __builtin_amdgcn_sched_barrier(0);
#pragma unroll
                for (int r8 = 0; r8 < 4; ++r8) { float kd[8];
#pragma unroll
                    for (int i = 0; i < 8; ++i) { const int rr = r8 * 8 + i, r = hf * 32 + rr; const float k = v[r] * ik[rr >> 2][rr & 3];
                        const bf16_t hi = f2bf(k); *(bf16_t*)(KH + r * GP_ROW * 2) = hi; *(bf16_t*)(KH + GP_TS + r * GP_ROW * 2) = f2bf(k - bf2f(hi)); kd[i] = k * ed[rr >> 2][rr & 3]; v[r] = k * be[rr >> 2][rr & 3]; }
                    u32x4 w; w.x = pk2(kd[0], kd[1]); w.y = pk2(kd[2], kd[3]); w.z = pk2(kd[4], kd[5]); w.w = pk2(kd[6], kd[7]);
                    *(u32x4*)(KDT + (hf * 4 + r8) * 8) = w; }
            }
        } else {
            f32x4 bt[16];
#pragma unroll
            for (int g4 = 0; g4 < 16; ++g4) bt[g4] = sc4[g4];
            __builtin_amdgcn_sched_barrier(0);
#pragma unroll
            for (int r = 0; r < 64; ++r) v[r] *= bt[r >> 2][r & 3];
        }
    }
    __syncthreads();
    {
        const int fr = lane & 15, fq = lane >> 4, mat = wid >> 2, mt = wid & 3;
        unsigned xo_ = (mat ? GP_QH : GP_KH) + (fr * GP_ROW + fq * 8) * 2, ko_ = GP_KH + (fr * GP_ROW + fq * 8) * 2, lo_ = GP_L; asm volatile("" : "+v"(xo_), "+v"(ko_), "+v"(lo_));
        const unsigned char* XH = lds + xo_; const unsigned char* XL = XH + GP_TS;
        const unsigned char* KH = lds + ko_; const unsigned char* KL = KH + GP_TS;
        float* Ls = (float*)(lds + lo_); bf16_t* AM = GI + G_A + (size_t)item * 4096;
        bf16x8 xh[4], xl[4];
#pragma unroll
        for (int ks = 0; ks < 4; ++ks) { const int off = (mt * 16 * GP_ROW + ks * 32) * 2; xh[ks] = *(const bf16x8*)(XH + off); xl[ks] = *(const bf16x8*)(XL + off); }
#pragma unroll
        for (int nt = 0; nt < 4; ++nt) {
            f32x4 acc = {0.f, 0.f, 0.f, 0.f};
#pragma unroll
            for (int ks = 0; ks < 4; ++ks) { const int off = (nt * 16 * GP_ROW + ks * 32) * 2; const bf16x8 kh = *(const bf16x8*)(KH + off), kl = *(const bf16x8*)(KL + off);
                acc = __builtin_amdgcn_mfma_f32_16x16x32_bf16(xh[ks], kh, acc, 0, 0, 0);
                acc = __builtin_amdgcn_mfma_f32_16x16x32_bf16(xh[ks], kl, acc, 0, 0, 0);
                acc = __builtin_amdgcn_mfma_f32_16x16x32_bf16(xl[ks], kh, acc, 0, 0, 0); }
            const int jj = nt * 16 + fr; const float gj = sGc[jj];
#pragma unroll
            for (int j = 0; j < 4; ++j) { const int i = mt * 16 + fq * 4 + j; const float gi = sGc[i];
                const float dec = __expf(jj <= i ? gi - gj : 0.f);
                if (mat == 0) Ls[i * 68 + jj] = jj < i ? sBeta[i] * acc[j] * dec : 0.f;
                else AM[i * 64 + jj] = f2bf(jj <= i ? acc[j] * dec : 0.f); }
        }
    }
    __syncthreads();
    if (tid >= 128 && tid < 384) {
        unsigned lb_ = GP_L; asm volatile("" : "+v"(lb_));
        const f32x4* L4 = (const f32x4*)(lds + lb_);
#pragma unroll
        for (int jb = 0; jb < 16; ++jb) {
            const int j0 = 4 * jb;
            { const f32x4 d1 = L4[(j0 + 1) * 17 + jb], d2 = L4[(j0 + 2) * 17 + jb], d3 = L4[(j0 + 3) * 17 + jb];
              v[j0 + 1] -= d1.x * v[j0];
              v[j0 + 2] -= d2.x * v[j0] + d2.y * v[j0 + 1];
              v[j0 + 3] -= d3.x * v[j0] + d3.y * v[j0 + 1] + d3.z * v[j0 + 2]; }
#pragma unroll
            for (int i0 = j0 + 4; i0 < 64; i0 += 20) {
                f32x4 l[20];
#pragma unroll
                for (int k = 0; k < 20; ++k) if (i0 + k < 64) l[k] = L4[(i0 + k) * 17 + jb];
                __builtin_amdgcn_sched_barrier(0);
#pragma unroll
                for (int k = 0; k < 20; ++k) if (i0 + k < 64) v[i0 + k] -= (l[k].x * v[j0] + l[k].y * v[j0 + 1]) + (l[k].z * v[j0 + 2] + l[k].w * v[j0 + 3]);
            }
        }
        if (role == 2) { bf16_t* UT = GI + G_UT + (size_t)item * 8192 + (size_t)c * 64;
#pragma unroll
            for (int r8 = 0; r8 < 8; ++r8) { u32x4 w; w.x = pk2(v[r8 * 8], v[r8 * 8 + 1]); w.y = pk2(v[r8 * 8 + 2], v[r8 * 8 + 3]); w.z = pk2(v[r8 * 8 + 4], v[r8 * 8 + 5]); w.w = pk2(v[r8 * 8 + 6], v[r8 * 8 + 7]); *(u32x4*)(UT + r8 * 8) = w; }
        } else { bf16_t* Wm = GI + G_W + (size_t)item * 8192 + c; unsigned woff = 0;
#pragma unroll
            for (int r = 0; r < 64; ++r) { *(bf16_t*)((char*)Wm + woff) = f2bf(v[r]); woff += 256; asm volatile("" : "+v"(woff)); } }
    }
    __syncthreads();
}

constexpr int SC_SLOT = 61696;
constexpr int SC_W = 0, SC_QG = 16384, SC_KD = 32768, SC_A = 49152, SC_U = 57344, SC_GL = 61440;
constexpr int SC_ST = 2 * SC_SLOT;
constexpr int SC_VN = SC_ST + 2 * 32 * 136 * 2;
constexpr int SC_PFD = SC_VN + 32 * 72 * 2;
static_assert(SC_PFD + 256 <= LDS_BYTES - 16, "scan LDS map");
__device__ __forceinline__ void gdn_scan_item(unsigned char* lds, const Args& a, int seq, int h, int es, int tid_in) {
    int tid_ = tid_in; asm volatile("" : "+v"(tid_));
    const int tid = tid_, lane = tid & 63, wid = tid >> 6, fr = lane & 15, fq = lane >> 4, mt = wid & 3, nt = wid >> 2;
    const int widu = __builtin_amdgcn_readfirstlane(wid);
    const bf16_t* GI = (const bf16_t*)(a.ws + B_R2); const float* GL = (const float*)(a.ws + B_GL);
    float* O = (float*)(a.ws + B_O);
    bf16_t* ST = (bf16_t*)(lds + SC_ST); bf16_t* VN = (bf16_t*)(lds + SC_VN);
    const int nsteps = seq == 0 ? 256 : 1, cidx0 = seq == 0 ? 0 : 255 + seq, row00 = seq == 0 ? 0 : MP + (seq - 1) * 64;
    f32x4 S[2];
#pragma unroll
    for (int n = 0; n < 2; ++n) {
        if (seq == 0) S[n] = (f32x4){0.f, 0.f, 0.f, 0.f};
        else { const float* sp = a.in[7] + ((size_t)((seq - 1) * 12 + h) * 128 + wid * 16 + fq * 4) * 128 + es * 32 + n * 16 + fr;
            S[n] = (f32x4){sp[0], sp[128], sp[256], sp[384]}; }
    }
    const char* rp[8]; int rstep[8], sdst[8];
    const size_t item0 = (size_t)(cidx0 * 12 + h);
#pragma unroll
    for (int i = 0; i < 8; ++i) { const int n = widu * 8 + i; const bf16_t* p = GI; int st = 8192, ds = 0;
        if (n < 32) { const int mm = n & 15, row = 4 * mm + (lane >> 4), c16 = (lane & 15) ^ (row & 15); p = GI + (n < 16 ? G_W : G_QG) + row * 128 + c16 * 8; ds = (n < 16 ? SC_W : SC_QG) + mm * 1024; }
        else if (n < 48) { const int mm = n - 32, row = 8 * mm + (lane >> 3), c8 = (lane & 7) ^ ((row >> 1) & 7); p = GI + G_KDT + row * 64 + c8 * 8; ds = SC_KD + mm * 1024; }
        else if (n < 56) { const int mm = n - 48, row = 8 * mm + (lane >> 3), c8 = (lane & 7) ^ ((row >> 1) & 7); p = GI + G_A + row * 64 + c8 * 8; st = 4096; ds = SC_A + mm * 1024; }
        else if (n < 60) { const int mm = n - 56, rl = 8 * mm + (lane >> 3), c8 = (lane & 7) ^ ((rl >> 1) & 7); p = GI + G_UT + (es * 32 + rl) * 64 + c8 * 8; ds = SC_U + mm * 1024; }
        else { p = (const bf16_t*)GL; st = 2; ds = SC_GL; }
        rp[i] = (const char*)p + item0 * (size_t)(st * 2); rstep[i] = 12 * st * 2; sdst[i] = ds; }
#define SCAN_DMA16(i_, slot_) do { __builtin_amdgcn_global_load_lds((const unsigned*)rp[i_], (LAS unsigned*)((LAS unsigned char*)lds + (slot_) * SC_SLOT + sdst[i_]), 16, 0, 0); rp[i_] += rstep[i_]; } while (0)
#define SCAN_ISSUE(slot_) do { if (widu < 7) { _Pragma("unroll") for (int i = 0; i < 8; ++i) SCAN_DMA16(i, slot_); } \
        else { _Pragma("unroll") for (int i = 0; i < 4; ++i) SCAN_DMA16(i, slot_); \
               __builtin_amdgcn_global_load_lds((const unsigned*)rp[4], (LAS unsigned*)((LAS unsigned char*)lds + (slot_) * SC_SLOT + SC_GL), 4, 0, 0); rp[4] += rstep[4]; } } while (0)
#define SCAN_BAR() do { asm volatile("s_waitcnt lgkmcnt(0)" ::: "memory"); __builtin_amdgcn_s_barrier(); asm volatile("" ::: "memory"); } while (0)
    __syncthreads();
#pragma unroll
    for (int n = 0; n < 2; ++n) { u32x2 w; w.x = pk2(S[n][0], S[n][1]); w.y = pk2(S[n][2], S[n][3]); *(u32x2*)(ST + (n * 16 + fr) * 136 + wid * 16 + fq * 4) = w; }
    SCAN_ISSUE(0); if (nsteps > 1) SCAN_ISSUE(1);
    float* opv = O; f32x4 ocv = {0.f, 0.f, 0.f, 0.f};
    for (int s = 0; s < nsteps; ++s) {
        if (s + 1 >= nsteps) asm volatile("s_waitcnt vmcnt(0)" ::: "memory");
        else if (s < 2) { if (widu == 7) asm volatile("s_waitcnt vmcnt(5)" ::: "memory"); else asm volatile("s_waitcnt vmcnt(8)" ::: "memory"); }
        else { if (widu == 7) asm volatile("s_waitcnt vmcnt(9)" ::: "memory"); else asm volatile("s_waitcnt vmcnt(12)" ::: "memory"); }
        SCAN_BAR();
        const unsigned char* sb = lds + (s & 1) * SC_SLOT;
        const bf16_t* STc = ST + (s & 1) * 32 * 136; bf16_t* STn = ST + ((s & 1) ^ 1) * 32 * 136;
        bf16x8 st[4], wf[4], qgf[4];
#pragma unroll
        for (int ks = 0; ks < 4; ++ks) { st[ks] = *(const bf16x8*)(STc + (nt * 16 + fr) * 136 + ks * 32 + fq * 8);
            wf[ks] = *(const bf16x8*)(sb + SC_W + (mt * 16 + fr) * 256 + (((ks * 4 + fq) ^ fr) * 16));
            qgf[ks] = *(const bf16x8*)(sb + SC_QG + (mt * 16 + fr) * 256 + (((ks * 4 + fq) ^ fr) * 16)); }
        const u32x2 uu = *(const u32x2*)(sb + SC_U + (nt * 16 + fr) * 128 + (((mt * 2 + (fq >> 1)) ^ (fr >> 1)) * 16) + (fq & 1) * 8);
        const float gl = *(const float*)(sb + SC_GL);
        f32x4 acc = {0.f, 0.f, 0.f, 0.f};
#pragma unroll
        for (int ks = 0; ks < 4; ++ks) acc = __builtin_amdgcn_mfma_f32_16x16x32_bf16(wf[ks], st[ks], acc, 0, 0, 0);
        asm volatile("s_nop 7\n\ts_nop 7" ::: "memory");
        float vn[4];
        vn[0] = __uint_as_float(uu.x << 16) - acc[0]; vn[1] = __uint_as_float(uu.x & 0xffff0000u) - acc[1]; vn[2] = __uint_as_float(uu.y << 16) - acc[2]; vn[3] = __uint_as_float(uu.y & 0xffff0000u) - acc[3];
        { u32x2 w; w.x = pk2(vn[0], vn[1]); w.y = pk2(vn[2], vn[3]); *(u32x2*)(VN + (nt * 16 + fr) * 72 + mt * 16 + fq * 4) = w; }
        f32x4 oc = {0.f, 0.f, 0.f, 0.f};
#pragma unroll
        for (int ks = 0; ks < 4; ++ks) oc = __builtin_amdgcn_mfma_f32_16x16x32_bf16(qgf[ks], st[ks], oc, 0, 0, 0);
        asm volatile("s_nop 7\n\ts_nop 7" ::: "memory");
#pragma unroll
        for (int n = 0; n < 2; ++n) S[n] *= gl;
        bf16x8 kdf[2], amf[2];
#pragma unroll
        for (int ks = 0; ks < 2; ++ks) { kdf[ks] = *(const bf16x8*)(sb + SC_KD + (wid * 16 + fr) * 128 + (((ks * 4 + fq) ^ (fr >> 1)) * 16));
            amf[ks] = *(const bf16x8*)(sb + SC_A + (mt * 16 + fr) * 128 + (((ks * 4 + fq) ^ (fr >> 1)) * 16)); }
        SCAN_BAR();
        if (s > 0) {
#pragma unroll
            for (int j = 0; j < 4; ++j) opv[(size_t)j * 1536] = ocv[j]; }
        if (s + 2 < nsteps) SCAN_ISSUE(s & 1);
#pragma unroll
        for (int n = 0; n < 2; ++n) {
#pragma unroll
            for (int ks = 0; ks < 2; ++ks) { const bf16x8 vb = *(const bf16x8*)(VN + (n * 16 + fr) * 72 + ks * 32 + fq * 8); S[n] = __builtin_amdgcn_mfma_f32_16x16x32_bf16(kdf[ks], vb, S[n], 0, 0, 0); asm volatile("s_nop 7\n\ts_nop 7" ::: "memory"); } }
#pragma unroll
        for (int n = 0; n < 2; ++n) { u32x2 w; w.x = pk2(S[n][0], S[n][1]); w.y = pk2(S[n][2], S[n][3]); *(u32x2*)(STn + (n * 16 + fr) * 136 + wid * 16 + fq * 4) = w; }
#pragma unroll
        for (int ks = 0; ks < 2; ++ks) { const bf16x8 vb = *(const bf16x8*)(VN + (nt * 16 + fr) * 72 + ks * 32 + fq * 8); oc = __builtin_amdgcn_mfma_f32_16x16x32_bf16(amf[ks], vb, oc, 0, 0, 0); asm volatile("s_nop 7\n\ts_nop 7" ::: "memory"); }
        opv = O + (size_t)(row00 + s * 64 + mt * 16 + fq * 4) * 1536 + h * 128 + es * 32 + nt * 16 + fr; ocv = oc;
    }
#pragma unroll
    for (int j = 0; j < 4; ++j) opv[(size_t)j * 1536] = ocv[j];
    __syncthreads();
    float* dp = seq == 0 ? a.out + O_DELTA_P + (size_t)h * 16384 : a.out + O_DELTA_S + (size_t)((seq - 1) * 12 + h) * 16384;
#pragma unroll
    for (int n = 0; n < 2; ++n)
#pragma unroll
        for (int j = 0; j < 4; ++j) dp[(size_t)(wid * 16 + fq * 4 + j) * 128 + es * 32 + n * 16 + fr] = S[n][j];
}

constexpr int AT_BUF = 65536;
constexpr int AT_KOFF = 0, AT_VOFF = 32768;
constexpr int AT_LUT = 2 * AT_BUF;
constexpr int AT_X = 0;
struct AttnItem {
    const bf16_t* q[2]; int ldq;
    const bf16_t* k[2]; int ldk;
    const bf16_t* vt[2]; int ldvt;
    int nkt;
    int qpos0;
    bf16_t* out; int ldo;
};
template <bool MEM>
__device__ __forceinline__ void attn_item(unsigned char* lds, const AttnItem& it, float lam, const float* subln, int tid_in) {
    constexpr int NETW = MEM ? 8 : 16;
    int tid_ = tid_in; asm volatile("" : "+v"(tid_));
    const int tid = tid_, lane = tid & 63, wid = tid >> 6, fr = lane & 15, fq = lane >> 4, g = wid >> 2, qr0 = (wid & 3) * 16;
    const int et0 = MEM ? 8 * g : 0;
    const float* LUT = (const float*)(lds + AT_LUT);
    const int widu = __builtin_amdgcn_readfirstlane(wid);
    bf16x8 qf[4];
#pragma unroll
    for (int ks = 0; ks < 4; ++ks) qf[ks] = *(const bf16x8*)((g ? it.q[1] : it.q[0]) + (size_t)(qr0 + fr) * it.ldq + ks * 32 + fq * 8);
    unsigned koff[8];
#pragma unroll
    for (int i = 0; i < 8; ++i) { const int n = widu * 8 + i;
        if (widu < 4) { const int row = (n & 15) * 4 + (lane >> 4), c16 = (lane & 15) ^ (row & 15); const int key = 32 * (row >> 5) + 8 * ((row >> 2) & 3) + 4 * ((row >> 4) & 1) + (row & 3);
            koff[i] = (unsigned)(key * it.ldk + c16 * 8) * 2u; }
        else { const int row = (n - 32) * 8 + (lane >> 3), c8 = (lane & 7) ^ ((row >> 1) & 7);
            koff[i] = (unsigned)((row & 127) * it.ldvt + c8 * 8) * 2u; } }
    const char* ksrc = (const char*)(widu < 2 ? it.k[0] : it.k[1]);
    const char* vsrc = (const char*)(widu < 6 ? it.vt[0] : it.vt[1]);
    const size_t kstep = (size_t)64 * it.ldk * 2;
#define ATT_ISSUE(kt_, bsel_) do { LAS unsigned char* dst_ = (LAS unsigned char*)lds + (bsel_) * AT_BUF + (widu < 4 ? AT_KOFF + widu * 8192 : AT_VOFF + (widu - 4) * 8192); \
        const char* src_ = widu < 4 ? ksrc + (size_t)(kt_) * kstep : vsrc + (size_t)(kt_) * 128; \
        _Pragma("unroll") for (int i = 0; i < 8; ++i) __builtin_amdgcn_global_load_lds((const unsigned*)(src_ + koff[i]), (LAS unsigned*)(dst_ + i * 1024), 16, 0, 0); } while (0)
#define ATT_BAR() do { asm volatile("s_waitcnt vmcnt(0) lgkmcnt(0)" ::: "memory"); __builtin_amdgcn_s_barrier(); asm volatile("" ::: "memory"); } while (0)
    f32x4 O[NETW];
#pragma unroll
    for (int e = 0; e < NETW; ++e) O[e] = (f32x4){0.f, 0.f, 0.f, 0.f};
    float mrun = -INFINITY, lsum = 0.f;
    const float sc = 0.08838834764831845f * LOG2E;
    __syncthreads();
    ATT_ISSUE(0, 0);
    for (int kt = 0; kt < it.nkt; ++kt) {
        const int bsel = kt & 1;
        ATT_BAR();
        if (kt + 1 < it.nkt) ATT_ISSUE(kt + 1, bsel ^ 1);
        const unsigned char* KTr = lds + bsel * AT_BUF + AT_KOFF; const unsigned char* VTr = lds + bsel * AT_BUF + AT_VOFF;
        f32x4 S[4];
#pragma unroll
        for (int t = 0; t < 4; ++t) S[t] = (f32x4){0.f, 0.f, 0.f, 0.f};
        {
            bf16x8 kf[4][4];
            const unsigned char* kb = KTr + g * 16384 + fr * 256;
#pragma unroll
            for (int ks = 0; ks < 4; ++ks)
#pragma unroll
                for (int t = 0; t < 4; ++t) kf[ks][t] = *(const bf16x8*)(kb + t * 4096 + (((ks * 4 + fq) ^ fr) * 16));
            __builtin_amdgcn_sched_barrier(0);
#pragma unroll
            for (int ks = 0; ks < 4; ++ks)
#pragma unroll
                for (int t = 0; t < 4; ++t) S[t] = __builtin_amdgcn_mfma_f32_16x16x32_bf16(kf[ks][t], qf[ks], S[t], 0, 0, 0);
        }
        u32x4 vf[2][8];
        const unsigned char* vbase = VTr + (et0 * 16 + fr) * 128;
#define ATT_LDV(buf, grp) do { _Pragma("unroll") for (int e4 = 0; e4 < 4; ++e4) _Pragma("unroll") for (int kb = 0; kb < 2; ++kb) \
            vf[buf][e4 * 2 + kb] = *(const u32x4*)(vbase + ((grp) * 4 + e4) * 2048 + (((kb * 4 + fq) ^ (fr >> 1)) * 16)); } while (0)
        __builtin_amdgcn_sched_barrier(0);
        ATT_LDV(0, 0);
        __builtin_amdgcn_sched_barrier(0);
        float mloc = -INFINITY, fs = 1.f, fa = 0.f;
        if (!MEM) {
            const int relb = kt * 64 + fq * 8 - (it.qpos0 + qr0 + fr);
            if (kt * 64 + 63 - (it.qpos0) <= -128) {
                const float bc = LUT[0];
#pragma unroll
                for (int t = 0; t < 4; ++t)
#pragma unroll
                    for (int j = 0; j < 4; ++j) mloc = fmaxf(mloc, S[t][j]);
                mloc = mloc * sc + bc; fs = sc; fa = bc;
            } else {
#pragma unroll
                for (int t = 0; t < 4; ++t)
#pragma unroll
                    for (int j = 0; j < 4; ++j) { int rel = relb + 32 * (t >> 1) + 4 * (t & 1) + j; rel = rel < -128 ? -128 : rel; S[t][j] = S[t][j] * sc + LUT[rel + 128]; mloc = fmaxf(mloc, S[t][j]); }
            }
        } else {
#pragma unroll
            for (int t = 0; t < 4; ++t)
#pragma unroll
                for (int j = 0; j < 4; ++j) mloc = fmaxf(mloc, S[t][j]);
            mloc *= sc; fs = sc;
        }
        mloc = fmaxf(mloc, shx(mloc, 16, lane)); mloc = fmaxf(mloc, shx(mloc, 32, lane));
        if (__builtin_amdgcn_ballot_w64(mloc > mrun)) {
            const float mnew = fmaxf(mrun, mloc), alpha = __builtin_amdgcn_exp2f(mrun - mnew);
            mrun = mnew; lsum *= alpha;
#pragma unroll
            for (int e = 0; e < NETW; ++e) O[e] *= alpha;
        }
        float ps = 0.f;
#pragma unroll
        for (int t = 0; t < 4; ++t)
#pragma unroll
            for (int j = 0; j < 4; ++j) { S[t][j] = __builtin_amdgcn_exp2f(__builtin_fmaf(S[t][j], fs, fa - mrun)); ps += S[t][j]; }
        lsum += ps;
        bf16x8 pf[2];
#pragma unroll
        for (int kb = 0; kb < 2; ++kb) { u32x4 w; w.x = pk2(S[2 * kb][0], S[2 * kb][1]); w.y = pk2(S[2 * kb][2], S[2 * kb][3]); w.z = pk2(S[2 * kb + 1][0], S[2 * kb + 1][1]); w.w = pk2(S[2 * kb + 1][2], S[2 * kb + 1][3]);
            pf[kb] = __builtin_bit_cast(bf16x8, w); }
#pragma unroll
        for (int grp = 0; grp < NETW / 4; ++grp) {
            if (grp + 1 < NETW / 4) { if ((grp & 1) == 0) ATT_LDV(1, grp + 1); else ATT_LDV(0, grp + 1); }
            __builtin_amdgcn_sched_barrier(0);
#pragma unroll
            for (int e4 = 0; e4 < 4; ++e4)
#pragma unroll
                for (int kb = 0; kb < 2; ++kb) O[grp * 4 + e4] = __builtin_amdgcn_mfma_f32_16x16x32_bf16(__builtin_bit_cast(bf16x8, vf[grp & 1][e4 * 2 + kb]), pf[kb], O[grp * 4 + e4], 0, 0, 0);
            __builtin_amdgcn_sched_barrier(0);
        }
    }
    lsum += shx(lsum, 16, lane); lsum += shx(lsum, 32, lane);
    const float inv = 1.f / lsum;
    if (MEM) {
        bf16_t* op = it.out + (size_t)(qr0 + fr) * it.ldo + g * 128 + fq * 4;
#pragma unroll
        for (int e = 0; e < NETW; ++e) { u32x2 w; w.x = pk2(O[e][0] * inv, O[e][1] * inv); w.y = pk2(O[e][2] * inv, O[e][3] * inv); *(u32x2*)(op + e * 16) = w; }
    } else {
        float* X = (float*)(lds + AT_X);
        __syncthreads();
        if (g == 1) {
#pragma unroll
            for (int e = 0; e < NETW; ++e) *(f32x4*)(X + (qr0 + fr) * 260 + e * 16 + fq * 4) = O[e] * (inv * lam);
        }
        __syncthreads();
        if (g == 0) {
            float ss = 0.f;
#pragma unroll
            for (int e = 0; e < NETW; ++e) { const f32x4 x = *(const f32x4*)(X + (qr0 + fr) * 260 + e * 16 + fq * 4); O[e] = O[e] * inv - x; ss += (O[e][0] * O[e][0] + O[e][1] * O[e][1]) + (O[e][2] * O[e][2] + O[e][3] * O[e][3]); }
            ss += shx(ss, 16, lane); ss += shx(ss, 32, lane);
            const float rs = rsqrtf(ss * (1.f / 256.f) + EPSF) * (1.f - LAM0);
            bf16_t* op = it.out + (size_t)(qr0 + fr) * it.ldo + fq * 4;
#pragma unroll
            for (int e = 0; e < NETW; ++e) { const f32x4 gn = *(const f32x4*)(subln + e * 16 + fq * 4); u32x2 w; w.x = pk2(O[e][0] * rs * gn.x, O[e][1] * rs * gn.y); w.y = pk2(O[e][2] * rs * gn.z, O[e][3] * rs * gn.w); *(u32x2*)(op + e * 16) = w; }
        }
    }
}
__device__ __forceinline__ void mem_attn_item(unsigned char* lds, const Args& a, int l, int rt, int hp, const bf16_t* QB, int ldq, int qcol, int tid_in) {
    const int seq = rt < 256 ? 0 : rt - 255;
    const bf16_t* MK = (const bf16_t*)(a.ws + B_MK) + (size_t)(l * 9 + seq) * 4 * 256 * 128;
    const bf16_t* MVT = (const bf16_t*)(a.ws + B_MVT) + (size_t)(l * 9 + seq) * 4 * 256 * 128;
    AttnItem it; const int h0 = hp * 2;
    it.q[0] = QB + (size_t)rt * 64 * ldq + qcol + h0 * 128; it.q[1] = it.q[0] + 128; it.k[0] = MK + (size_t)h0 * 256 * 128; it.k[1] = it.k[0] + 256 * 128; it.vt[0] = MVT + (size_t)h0 * 128 * 256; it.vt[1] = it.vt[0] + 128 * 256;
    it.ldq = ldq; it.ldk = 128; it.ldvt = 256; it.nkt = 4; it.qpos0 = 0;
    it.out = (bf16_t*)(a.ws + B_MIX) + (size_t)rt * 64 * DM + 1536 + hp * 256; it.ldo = DM;
    attn_item<true>(lds, it, 0.f, nullptr, tid_in);
}

#define XB_TMO      128
#define XB_XCNT(j)  (256  + 64 * (j))
#define XB_XSUB(j)  (1280 + 64 * (j))
#define XB_XGEN(j)  (2304 + 64 * (j))
#define XB_TOP      3328
#define XB_TOPGEN   3392
#define XCD_BAR_WORDS 3456
#define XB_SPIN_CAP (1u << 18)


__device__ __forceinline__ unsigned xb_ld(unsigned* p)              { return __hip_atomic_load(p, __ATOMIC_RELAXED, __HIP_MEMORY_SCOPE_AGENT); }
__device__ __forceinline__ unsigned xb_add(unsigned* p, unsigned v) { return __hip_atomic_fetch_add(p, v, __ATOMIC_RELAXED, __HIP_MEMORY_SCOPE_AGENT); }
__device__ __forceinline__ unsigned xb_xcc_id() { return (unsigned)__builtin_amdgcn_s_getreg((3 << 11) | 20) & 0xFu; }
#define XB_SPIN(cond, bar) do { unsigned _sp = 0; while (cond) { __builtin_amdgcn_s_sleep(1); \
    if ((++_sp & 255u) == 0u) { if (xb_ld(&(bar)[XB_TMO])) break; if (_sp > XB_SPIN_CAP) { atomicAdd(&(bar)[XB_TMO], 1u); break; } } } } while (0)

struct XcdBarrier {
    unsigned* bar; unsigned x;
    volatile LAS unsigned* st;
};

__device__ __forceinline__ XcdBarrier xcd_barrier_post(unsigned* bar, volatile LAS unsigned* st) {
    XcdBarrier b; b.bar = bar; b.x = xb_xcc_id(); b.st = st;
    if (threadIdx.x == 0) (void)xb_add(&bar[XB_XCNT(b.x)], 1u);
    return b;
}
__device__ __forceinline__ void xcd_barrier_complete(unsigned* bar, unsigned x, unsigned& nloc, unsigned& nx) {
    const unsigned G = gridDim.x * gridDim.y * gridDim.z;
    unsigned sum, cnt, mine, sp = 0u;
    for (;;) {
        sum = 0u; cnt = 0u; mine = 0u;
#pragma unroll
        for (unsigned j = 0; j < 16; ++j) { const unsigned c = xb_ld(&bar[XB_XCNT(j)]); sum += c; cnt += (c > 0u) ? 1u : 0u; mine = (j == x) ? c : mine; }
        if (sum == G) break;
        __builtin_amdgcn_s_sleep(1);
        if ((++sp & 255u) == 0u) { if (xb_ld(&bar[XB_TMO])) break; if (sp > XB_SPIN_CAP) { atomicAdd(&bar[XB_TMO], 1u); break; } }
    }
    nloc = mine > 0u ? mine : 1u; nx = cnt > 0u ? cnt : 1u;
}

__device__ __forceinline__ void xcd_barrier(const XcdBarrier& b) {
    asm volatile("s_waitcnt vmcnt(0)" ::: "memory");
    __syncthreads();
    if (threadIdx.x == 0) {
        unsigned* bar = b.bar;
        __builtin_amdgcn_s_waitcnt(0);
        unsigned nloc = b.st[0], nx = b.st[1];
        if (nloc == 0u) { xcd_barrier_complete(bar, b.x, nloc, nx); b.st[0] = nloc; b.st[1] = nx; }
        const unsigned old = xb_add(&bar[XB_XSUB(b.x)], 1u);
        const unsigned gen = old / nloc;
        if (old + 1u == (gen + 1u) * nloc) {
            __builtin_amdgcn_fence(__ATOMIC_RELEASE, "agent");
            asm volatile("s_waitcnt vmcnt(0)" ::: "memory");
            const unsigned og = xb_add(&bar[XB_TOP], 1u);
            const unsigned tg = og / nx;
            if (og + 1u == (tg + 1u) * nx) xb_add(&bar[XB_TOPGEN], 1u);
            else XB_SPIN(xb_ld(&bar[XB_TOPGEN]) == tg, bar);
            __builtin_amdgcn_fence(__ATOMIC_ACQUIRE, "agent");
            xb_add(&bar[XB_XGEN(b.x)], 1u);
            asm volatile("s_waitcnt vmcnt(0)" ::: "memory");
        } else {
            XB_SPIN(xb_ld(&bar[XB_XGEN(b.x)]) == gen, bar);
            __builtin_amdgcn_fence(__ATOMIC_ACQUIRE, "agent");
            asm volatile("s_waitcnt vmcnt(0)" ::: "memory");
        }
    }
    __syncthreads();
}

constexpr int NPHASE = 24;
__global__ void __launch_bounds__(NT, 2) fwd_kernel(Args a0) {
    extern __shared__ __attribute__((aligned(16))) unsigned char lds[];
    cg::grid_group grid = cg::this_grid();
    LAS unsigned char* glds = (LAS unsigned char*)lds;
    const int hi = a0.ph_hi < NPHASE ? a0.ph_hi : NPHASE;
#ifndef REPMASK
#define REPMASK 0
#endif
    int rep = 0; const int repmask = a0.repmask;
    volatile LAS unsigned* xst = (volatile LAS unsigned*)(glds + LDS_BYTES - 16);
    if (threadIdx.x < 4) xst[threadIdx.x] = 0u;
    __syncthreads();
    const XcdBarrier xbar = xcd_barrier_post((unsigned*)(a0.ws + B_BAR), xst);
    const int wid0 = __builtin_amdgcn_readfirstlane(threadIdx.x >> 6);
#pragma unroll 1
    for (int ph = a0.ph_lo; ph < hi; ) {
        typedef const __attribute__((address_space(4))) char* kptr_t;
        kptr_t kp = (kptr_t)__builtin_amdgcn_kernarg_segment_ptr();
        int tid_ = wid0 * 64 + (int)__builtin_amdgcn_mbcnt_hi(~0u, __builtin_amdgcn_mbcnt_lo(~0u, 0u)), bid_ = blockIdx.x, G_ = gridDim.x;
        asm volatile("" : "+v"(tid_), "+s"(bid_), "+s"(G_), "+s"(kp));
        Args a;
#pragma unroll
        for (int i = 0; i < 26; ++i) a.in[i] = *(const float* const __attribute__((address_space(4)))*)(kp + 8 * i);
        a.out = *(float* const __attribute__((address_space(4)))*)(kp + 208); a.ws = *(unsigned char* const __attribute__((address_space(4)))*)(kp + 216); a.ph_lo = 0; a.ph_hi = 0;
        unsigned char* ws = a.ws;
        const int tid = tid_, bid = bid_, G = G_;
#define LANE_WID const int lane = tid & 63, wid = __builtin_amdgcn_readfirstlane(tid >> 6), gw = bid * 8 + wid, ngw = G * 8; (void)gw; (void)ngw; (void)wid; (void)lane;
        bf16_t* XN = (bf16_t*)(ws + B_XN); bf16_t* MIX = (bf16_t*)(ws + B_MIX); bf16_t* R1 = (bf16_t*)(ws + B_R1);
        float* Dbuf = (float*)(ws + B_R2);
        const float* NG = a.in[9];
        int kind;
        switch (ph) { case 0: kind = 0; break; case 3: case 9: case 12: case 16: case 20: case 23: kind = 2; break; case 5: kind = 3; break; case 6: kind = 4; break; case 7: kind = 5; break; case 18: kind = 6; break; default: kind = 1; }
        if (kind == 0) {
            LANE_WID
            float* scr = (float*)(lds + wid * 8704);
            conv_weight<1>(a.in[10], DM, NGU, NGU, (bf16_t*)(ws + W_GU), scr, gw, ngw, lane);
            conv_weight<0>(a.in[11], FF, DM, DM, (bf16_t*)(ws + W_DN), scr, gw, ngw, lane);
            conv_weight<0>(a.in[15], DM, INA, INA_P, (bf16_t*)(ws + W_INA), scr, gw, ngw, lane);
            for (int i = 0; i < 2; ++i) conv_weight<0>(a.in[14] + (size_t)i * DM * 1024, DM, 1024, 1024, (bf16_t*)(ws + W_MEM + (size_t)i * 1024 * DM * 2), scr, gw, ngw, lane);
            for (int r = gw; r < MT; r += ngw) row_update(xrow(a, r), a.out + (size_t)r * DM, nullptr, 0.f, nullptr, NG, XN + (size_t)r * DM, nullptr, nullptr, lane);
            for (int r = gw; r < 512; r += ngw) { const int l = r >> 8, mm = r & 255;
                row_update(a.in[2] + (size_t)mm * DM, nullptr, nullptr, 0.f, nullptr, a.in[13] + l * DM, (bf16_t*)(ws + B_MEMN) + (size_t)r * DM, nullptr, nullptr, lane); }
            const size_t gt = (size_t)bid * NT + tid, ngt = (size_t)G * NT;
            { bf16_t* MK = (bf16_t*)(ws + B_MK); bf16_t* MVT = (bf16_t*)(ws + B_MVT);
              for (size_t i = gt; i < (size_t)2 * 8 * 256 * 512; i += ngt) { const size_t d = i & 127, hh = (i >> 7) & 3, mm = (i >> 9) & 255, b = (i >> 17) & 7, l = i >> 20;
                  MK[(((l * 9 + 1 + b) * 4 + hh) * 256 + mm) * 128 + d] = f2bf(a.in[5][i]);
                  MVT[(((l * 9 + 1 + b) * 4 + hh) * 128 + d) * 256 + mm] = f2bf(a.in[6][i]); } }
        } else if (kind == 1) {
#pragma unroll 1
            for (int sub = 0; sub < 2; ++sub) {
                const bf16_t* A = nullptr; const bf16_t* B = nullptr; int M = MT, N = DM, K = DM, Gs = G, c = bid, ld = 0, mt = 1 << 20, ksl = 0; EpiBase E{0, nullptr, nullptr, nullptr, nullptr, DM};
                const bool split = ph == 2 || ph == 11 || ph == 15 || ph == 22 || ph == 8 || ph == 19;
                const int l = ph >= 13 ? 1 : 0;
                if (sub == 1) {
                    if (ph == 1) {
                        c = bid - (G - 8); if (c < 0) break; const int ll = c >> 2; c &= 3; Gs = 4; M = 256; N = 1024;
                        A = (const bf16_t*)(ws + B_MEMN) + (size_t)ll * 256 * DM; B = (const bf16_t*)(ws + W_MEM) + (size_t)ll * 1024 * DM;
                        E.mode = 4; E.f0 = a.out + O_MK_P + (size_t)ll * 256 * 512; E.f1 = a.out + O_MV_P + (size_t)ll * 256 * 512;
                    } else if (split) {
                        const int Kf = (ph == 8 || ph == 19) ? DM : FF; const int lyr = ph >= 13 ? 1 : 0;
                        if (ph == 8 || ph == 19) { A = MIX; B = (const bf16_t*)(ws + W_OUT + (size_t)lyr * SZ_WSQ); }
                        else { const int i = (ph == 2 || ph == 15) ? 0 : 1; A = R1; B = (const bf16_t*)(ws + W_DN + (size_t)(lyr * 2 + i) * SZ_WDN); }
                        A += (size_t)MP * Kf; M = (Kf / 512) * 512; K = 512; ld = Kf; mt = 2; ksl = 512; E.mode = 0; E.f0 = (float*)(ws + B_DP); E.ldc = DM;
                    } else break;
                } else {
                    switch (ph) {
                        case 1: case 10: case 14: case 21: { const int i = (ph == 1 || ph == 14) ? 0 : 1; A = XN; B = (const bf16_t*)(ws + W_GU + (size_t)(l * 2 + i) * SZ_WGU); N = NGU; E.mode = 1; E.b0 = R1; } break;
                        case 2: case 11: case 15: case 22: { const int i = (ph == 2 || ph == 15) ? 0 : 1; A = R1; B = (const bf16_t*)(ws + W_DN + (size_t)(l * 2 + i) * SZ_WDN); K = FF; E.mode = 2; E.b0 = (bf16_t*)Dbuf; E.ldc = DM; E.f0 = nullptr; } break;
                        case 4: A = XN; B = (const bf16_t*)(ws + W_INA); N = INA_P; E.mode = 2; E.b0 = R1; E.ldc = INA_P; E.f0 = (float*)(ws + B_LOG); break;
                        case 8: case 19: A = MIX; B = (const bf16_t*)(ws + W_OUT + (size_t)l * SZ_WSQ); E.mode = 2; E.b0 = (bf16_t*)Dbuf; E.ldc = DM; E.f0 = nullptr; break;
                        case 13: A = MIX; B = (const bf16_t*)(ws + W_KV); N = NKV; E.mode = 3; E.f0 = a.out; break;
                        default:   A = XN; B = (const bf16_t*)(ws + W_INB); N = INB; E.mode = 2; E.b0 = R1; E.ldc = INB; E.f0 = nullptr; break;
                    }
                }
                if (sub == 0 && split) M = MP;
                if (ld == 0) ld = K;
                pg8::Gemm g_{A, B, M, N, K, ld, mt, ksl}; pg8::StaticOrder S_; S_.init(M, N, Gs, c);
                if (E.mode == 1) { EpiSwigluG E1; *(EpiBase*)&E1 = E; pg8::gemm_phase<EpiSwigluG, pg8::StaticOrder, true, true>(glds, g_, S_, E1, tid); }
                else if (E.mode == 2) { EpiBf16G E2; *(EpiBase*)&E2 = E; pg8::gemm_phase<EpiBf16G, pg8::StaticOrder, true, true>(glds, g_, S_, E2, tid); }
                else { EpiF32G E0; *(EpiBase*)&E0 = E; pg8::gemm_phase<EpiF32G, pg8::StaticOrder, true, true>(glds, g_, S_, E0, tid); }
            }
        } else if (kind == 2) {
            LANE_WID
            const int l = ph >= 13 ? 1 : 0; const float* ng = NG + (size_t)l * 6 * DM;
            float coef = 0.5f; const float* g1; const float* g2; const float* g3 = nullptr;
            switch (ph) {
                case 3: case 16: g1 = ng + DM; g2 = ng + 2 * DM; break;
                case 9: case 20: coef = 1.0f; g1 = ng + 3 * DM; g2 = ng + 4 * DM; break;
                case 12: g1 = ng + 5 * DM; g2 = NG + 6 * DM; g3 = a.in[20]; break;
                default: g1 = ng + 5 * DM; g2 = nullptr; break;
            }
            phase_rowpass(a, Dbuf, coef, g1, g2, g3, gw, ngw, lane, (ph == 9 || ph == 20) ? 4 : 11);
            if (ph == 3) {
                bf16_t* MK = (bf16_t*)(ws + B_MK); bf16_t* MVT = (bf16_t*)(ws + B_MVT);
                for (size_t i = (size_t)bid * NT + tid; i < (size_t)2 * 256 * 512; i += (size_t)G * NT) { const size_t d = i & 127, hh = (i >> 7) & 3, mm = (i >> 9) & 255, l2 = i >> 17;
                    MK[(((l2 * 9) * 4 + hh) * 256 + mm) * 128 + d] = f2bf(a.out[O_MK_P + i]);
                    MVT[(((l2 * 9) * 4 + hh) * 128 + d) * 256 + mm] = f2bf(a.out[O_MV_P + i]); }
            }
            if (ph == 16) {
                float* scr = (float*)(lds + wid * 8704);
                conv_weight<0>(a.out + O_V_P, MP, 1536, 1536, (bf16_t*)(ws + B_VTP), scr, gw, ngw, lane);
                for (int b = 0; b < 8; ++b) conv_weight<0>(a.out + O_V_S + (size_t)b * 64 * 1536, 64, 1536, 1536, (bf16_t*)(ws + B_VTS) + (size_t)b * 1536 * 1088 + 1024, scr, gw, ngw, lane, 1088);
                const size_t gt = (size_t)bid * NT + tid, ngt = (size_t)G * NT;
                bf16_t* KP = (bf16_t*)(ws + B_KP); bf16_t* KS = (bf16_t*)(ws + B_KS);
                for (size_t i = gt; i < (size_t)MT * 192; i += ngt) { const size_t r = i / 192, c8 = i % 192;
                    const float* sp = (r < MP ? a.out + O_K_P + r * 1536 : a.out + O_K_S + (r - MP) * 1536) + c8 * 8;
                    const f32x4 x0 = *(const f32x4*)sp, x1 = *(const f32x4*)(sp + 4);
                    u32x4 w; w.x = pk2(x0.x, x0.y); w.y = pk2(x0.z, x0.w); w.z = pk2(x1.x, x1.y); w.w = pk2(x1.z, x1.w);
                    bf16_t* dp = r < MP ? KP + r * 1536 : KS + (((r - MP) >> 6) * 1088 + 1024 + ((r - MP) & 63)) * 1536;
                    *(u32x4*)(dp + c8 * 8) = w; }
            }
        } else if (kind == 3) {
            for (int it = bid; it < NITEM; it += G) gdn_prep_item(lds, a, it / 12, it % 12, tid);
            const size_t gt = (size_t)bid * NT + tid, ngt = (size_t)G * NT;
            for (size_t i = gt; i < (size_t)9 * 3 * 4608; i += ngt) { const int s = (int)(i / (3 * 4608)), rem = (int)(i % (3 * 4608)), j = rem / 4608, ch = rem % 4608;
                const int row = s == 0 ? MP - 3 + j : MP + (s - 1) * 64 + 61 + j;
                const float x = bf2f(R1[(size_t)row * INA_P + ch]);
                if (s == 0) a.out[O_CONV_P + rem] = x; else a.out[O_CONV_S + (size_t)(s - 1) * 3 * 4608 + rem] = x; }
        } else if (kind == 4) {
            const int c = bid - 48, GC = G - 48;
            for (int it = bid < 48 ? bid : 48 + c; it < 48 + 384; it += (bid < 48 ? 1 << 30 : GC)) {
                const int seq = it < 48 ? 0 : 1 + (it - 48) / 48, hh = it < 48 ? it >> 2 : ((it - 48) % 48) >> 2, es = it & 3;
                gdn_scan_item(lds, a, seq, hh, es, tid); __syncthreads(); }
            if (bid >= 48) for (int it = c; it < 528; it += GC) { mem_attn_item(lds, a, 0, it >> 1, it & 1, R1, INA_P, QMA, tid); __syncthreads(); }
            if (bid >= 48) {
                const int lane = tid & 63, wid = __builtin_amdgcn_readfirstlane(tid >> 6), gw2 = c * 8 + wid, ngw2 = GC * 8;
                float* scr = (float*)(lds + wid * 8704);
                for (int i = 1; i < 4; ++i) conv_weight<1>(a.in[10] + (size_t)i * DM * NGU, DM, NGU, NGU, (bf16_t*)(ws + W_GU + i * SZ_WGU), scr, gw2, ngw2, lane);
                for (int i = 1; i < 4; ++i) conv_weight<0>(a.in[11] + (size_t)i * FF * DM, FF, DM, DM, (bf16_t*)(ws + W_DN + i * SZ_WDN), scr, gw2, ngw2, lane);
                for (int i = 0; i < 2; ++i) conv_weight<0>(a.in[12] + (size_t)i * DM * DM, DM, DM, DM, (bf16_t*)(ws + W_OUT + i * SZ_WSQ), scr, gw2, ngw2, lane);
                conv_weight<0>(a.in[21], DM, NKV, NKV, (bf16_t*)(ws + W_KV), scr, gw2, ngw2, lane);
                conv_weight<0>(a.in[22], DM, INB, INB, (bf16_t*)(ws + W_INB), scr, gw2, ngw2, lane);
                for (int b = 0; b < 8; ++b) conv_weight<0>(a.in[4] + (size_t)b * 1024 * 1536, 1024, 1536, 1536, (bf16_t*)(ws + B_VTS) + (size_t)b * 1536 * 1088, scr, gw2, ngw2, lane, 1088);
                bf16_t* KS = (bf16_t*)(ws + B_KS);
                for (size_t i = (size_t)c * NT + tid; i < (size_t)8 * 1024 * 192; i += (size_t)GC * NT) { const size_t b = i / (1024 * 192), rem = i % (1024 * 192);
                    const f32x4 x0 = *(const f32x4*)(a.in[3] + i * 8), x1 = *(const f32x4*)(a.in[3] + i * 8 + 4);
                    u32x4 w; w.x = pk2(x0.x, x0.y); w.y = pk2(x0.z, x0.w); w.z = pk2(x1.x, x1.y); w.w = pk2(x1.z, x1.w);
                    *(u32x4*)(KS + b * 1088 * 1536 + rem * 8) = w; }
            }
        } else if (kind == 5) {
            const int lane = tid & 63;
            const float* O = (const float*)(ws + B_O); const float* on = a.in[19];
            const size_t gt = (size_t)bid * NT + tid, ngt = (size_t)G * NT;
            for (size_t i = gt; i < (size_t)MT * 192; i += ngt) { const size_t r = i / 192; const int hs = (int)(i % 192), hh = hs >> 4, sub = hs & 15;
                const float* op = O + r * 1536 + hh * 128 + sub * 8; const f32x4 o0 = *(const f32x4*)op, o1 = *(const f32x4*)(op + 4);
                float ss = (o0.x * o0.x + o0.y * o0.y) + (o0.z * o0.z + o0.w * o0.w) + (o1.x * o1.x + o1.y * o1.y) + (o1.z * o1.z + o1.w * o1.w);
                ss += shx(ss, 1, lane); ss += shx(ss, 2, lane); ss += shx(ss, 4, lane); ss += shx(ss, 8, lane);
                const float rs = rsqrtf(ss * (1.f / 128.f) + EPSF);
                const u32x4 zz = *(const u32x4*)(R1 + r * INA_P + 4608 + hh * 128 + sub * 8);
                const f32x4 g0 = *(const f32x4*)(on + sub * 8), g1 = *(const f32x4*)(on + sub * 8 + 4);
                float z[8]; z[0] = __uint_as_float(zz.x << 16); z[1] = __uint_as_float(zz.x & 0xffff0000u); z[2] = __uint_as_float(zz.y << 16); z[3] = __uint_as_float(zz.y & 0xffff0000u);
                z[4] = __uint_as_float(zz.z << 16); z[5] = __uint_as_float(zz.z & 0xffff0000u); z[6] = __uint_as_float(zz.w << 16); z[7] = __uint_as_float(zz.w & 0xffff0000u);
                u32x4 w; w.x = pk2(o0.x * rs * g0.x * siluf(z[0]), o0.y * rs * g0.y * siluf(z[1])); w.y = pk2(o0.z * rs * g0.z * siluf(z[2]), o0.w * rs * g0.w * siluf(z[3]));
                w.z = pk2(o1.x * rs * g1.x * siluf(z[4]), o1.y * rs * g1.y * siluf(z[5])); w.w = pk2(o1.z * rs * g1.z * siluf(z[6]), o1.w * rs * g1.w * siluf(z[7]));
                *(u32x4*)(MIX + r * DM + hh * 128 + sub * 8) = w; }
        } else {
            LANE_WID
            const float* lq = a.in[23];
            const float d0 = wave_sum(lq[lane] * lq[128 + lane] + lq[64 + lane] * lq[192 + lane], lane);
            const float d1 = wave_sum(lq[256 + lane] * lq[384 + lane] + lq[320 + lane] * lq[448 + lane], lane);
            const float lam = __expf(d0) - __expf(d1) + LAM0;
            const bf16_t* KP = (const bf16_t*)(ws + B_KP); const bf16_t* VTP = (const bf16_t*)(ws + B_VTP);
            const bf16_t* KS = (const bf16_t*)(ws + B_KS); const bf16_t* VTS = (const bf16_t*)(ws + B_VTS);
            float* LUT = (float*)(lds + AT_LUT);
            const int NPI = 256 * 6, NSI = 48, NMI = 528;
            const int nit = (G == 256) ? 7 : (NPI + NSI + G - 1) / G;
            for (int rnd = 0; rnd < nit; ++rnd) {
                int idx;
                if (G == 256) {
                    if (rnd < 6) { const int xcd = bid & 7, slot = bid >> 3; const int qb = (rnd & 1) ? 7 - xcd : xcd, s = (rnd & 1) ? 31 - slot : slot; idx = (255 - (qb * 32 + s)) * 6 + rnd; }
                    else idx = NPI + bid;
                } else { const int pos = (rnd & 1) ? (G - 1 - bid) : bid; idx = rnd * G + pos; }
                if (idx >= NPI + NSI) continue;
                __syncthreads();
                AttnItem it; int h;
                if (idx < NPI) { const int qt = 255 - idx / 6; h = idx % 6;
                    it.q[0] = R1 + (size_t)qt * 64 * INB + (h * 2) * 128; it.q[1] = it.q[0] + 128; it.k[0] = KP + (h * 2) * 128; it.k[1] = it.k[0] + 128; it.vt[0] = VTP + (size_t)(h * 256) * MP; it.vt[1] = it.vt[0] + (size_t)128 * MP;
                    it.ldq = INB; it.ldk = 1536; it.ldvt = MP; it.nkt = qt + 1; it.qpos0 = qt * 64; it.out = MIX + (size_t)qt * 64 * DM + h * 256; it.ldo = DM;
                } else { const int si = idx - NPI, b = si / 6; h = si % 6;
                    it.q[0] = R1 + (size_t)(MP + b * 64) * INB + (h * 2) * 128; it.q[1] = it.q[0] + 128; it.k[0] = KS + (size_t)b * 1088 * 1536 + (h * 2) * 128; it.k[1] = it.k[0] + 128;
                    it.vt[0] = VTS + ((size_t)b * 1536 + h * 256) * 1088; it.vt[1] = it.vt[0] + (size_t)128 * 1088;
                    it.ldq = INB; it.ldk = 1536; it.ldvt = 1088; it.nkt = 17; it.qpos0 = 1024; it.out = MIX + (size_t)(MP + b * 64) * DM + h * 256; it.ldo = DM;
                }
                if (tid < 192) { const int rel = tid - 128, n = rel < 0 ? -rel : rel; int bk;
                    if (n < 8) bk = n; else { int lg = 8 + (int)(__logf((float)n * 0.125f) / 2.772588722239781f * 8.f); bk = lg < 15 ? lg : 15; }
                    if (rel > 0) bk += 16;
                    LUT[tid] = a.in[25][bk * 6 + h] * LOG2E; }
                attn_item<false>(lds, it, lam, a.in[24], tid);
            }
            __syncthreads();
            { const int m0 = G > 96 ? bid - 48 : G - 1 - bid, ms = G > 96 ? G - 48 : G;
              for (int mi = m0; mi >= 0 && mi < NMI; mi += ms) { mem_attn_item(lds, a, 1, mi >> 1, mi & 1, R1, INB, 1536, tid); __syncthreads(); } }
        }
        if (a0.ph_lo < 0) grid.sync();
        if ((ph + 1 < hi) || (((repmask >> kind) & 1) && rep == 0)) xcd_barrier(xbar);
        if (((repmask >> kind) & 1) && rep == 0) rep = 1; else { rep = 0; ++ph; }
    }
}

extern "C" void kernel_launch(void* const* d_in, const int* in_sizes, int n_in, void* d_out, int out_size, void* d_ws, size_t ws_size, hipStream_t stream) {
    static int grid = 0;
    if (grid == 0) {
        int dev = 0, cus = 0, per_cu = 0;
        hipGetDevice(&dev);
        hipDeviceGetAttribute(&cus, hipDeviceAttributeMultiprocessorCount, dev);
        hipFuncSetAttribute((const void*)fwd_kernel, hipFuncAttributeMaxDynamicSharedMemorySize, LDS_BYTES);
        hipOccupancyMaxActiveBlocksPerMultiprocessor(&per_cu, (const void*)fwd_kernel, NT, LDS_BYTES);
        if (per_cu < 1) { fprintf(stderr, "kernel_launch: occupancy query says %d blocks/CU\n", per_cu); per_cu = 1; }
        grid = cus;
        if (ws_size < WS_END) { fprintf(stderr, "kernel_launch: workspace too small: %zu < %zu\n", ws_size, (size_t)WS_END); grid = -1; }
        if (n_in != 26) { fprintf(stderr, "kernel_launch: expected 26 inputs, got %d\n", n_in); grid = -1; }
    }
    if (grid < 0) return;
    Args a{};
    for (int i = 0; i < 26; ++i) a.in[i] = (const float*)d_in[i];
    a.out = (float*)d_out; a.ws = (unsigned char*)d_ws; a.ph_lo = 0; a.ph_hi = NPHASE; a.repmask = REPMASK; a.pad = 0;
    if (hipMemsetAsync((char*)d_ws + B_BAR, 0, 16384, stream) != hipSuccess) fprintf(stderr, "kernel_launch: memset of the barrier words failed\n");
    void* args[] = {&a};
    hipError_t e = hipLaunchCooperativeKernel((const void*)fwd_kernel, dim3(grid), dim3(NT), args, LDS_BYTES, stream);
    if (e != hipSuccess) fprintf(stderr, "cooperative launch failed: %s (grid %d)\n", hipGetErrorString(e), grid);
}
```

```cpp
#define REPMASK 0
#include <hip/hip_runtime.h>
#include <hip/hip_cooperative_groups.h>
#include <cstdio>
namespace cg = cooperative_groups;
namespace pg8 {
#define PG8_LAS __attribute__((address_space(3)))
typedef unsigned short bf16_t;
typedef short bf16x8 __attribute__((ext_vector_type(8)));
typedef float f32x4 __attribute__((ext_vector_type(4)));
typedef unsigned u32x4 __attribute__((ext_vector_type(4)));
constexpr int BM = 256, BK = 64, HALF = 128, HTB = HALF * BK * 2  , STAGE_BYTES = 8 * HTB, NXCD = 8, WGM = 4;

__host__ __device__ __forceinline__ int lds_byte(int r, int c) { const int st = (r >> 4) * 2 + (c >> 5), rr = r & 15, cc = c & 31, ob = rr * 64 + cc * 2; return st * 1024 + (ob ^ (((ob >> 9) & 1) << 5)); }
__host__ __device__ __forceinline__ void stage_rc(int b, int& R, int& C) { const int st = b / 1024, sb = b % 1024, swz = sb ^ (((sb >> 9) & 1) << 5); R = (st >> 1) * 16 + swz / 64; C = (st & 1) * 32 + (swz % 64) / 2; }
__host__ __device__ __forceinline__ int perm32(int rho) { const int n = rho >> 4, i = rho & 15; return 8 * (i >> 2) + 4 * n + (i & 3); }

struct Unit { int pm, pn; };
struct Gemm { const bf16_t* A; const bf16_t* Bt; int M, N, K; int ld, mt, ksl; };

struct StaticOrder {
    int nM, nN, nwg, G, c;
    __host__ __device__ void init(int M, int N, int G_, int c_) { nM = M / BM; nN = N / BM; nwg = nM * nN; G = G_; c = c_; }
    __host__ __device__ bool next(int i, Unit& u) const {
        const long L = (long)i * G + c; if (L >= nwg) return false;
        int wgid = (int)L; { const int q = nwg / NXCD, r = nwg % NXCD, xcd = wgid % NXCD, off = wgid / NXCD; wgid = (xcd < r ? xcd * (q + 1) : r * (q + 1) + (xcd - r) * q) + off; }
        const int nig = WGM * nN, gid = wgid / nig, fm = gid * WGM, gsz = (nM - fm) < WGM ? (nM - fm) : WGM;
        u.pm = fm + ((wgid % nig) % gsz); u.pn = (wgid % nig) / gsz; return true;
    }
    __device__ __forceinline__ void a_ready(const Unit&) const {}
    __device__ __forceinline__ void done(const Unit&) const {}
};
__device__ __forceinline__ unsigned cvt_pk_bf16(float lo, float hi) { unsigned r; asm volatile("v_cvt_pk_bf16_f32 %0, %1, %2" : "=v"(r) : "v"(lo), "v"(hi)); return r; }
typedef float f32x2 __attribute__((ext_vector_type(2)));
template <class Epi, class Sched, bool ALIGN_EPI = false, bool SP2 = false>
__device__ __forceinline__ void gemm_phase(PG8_LAS unsigned char* lds, const Gemm g, const Sched& S, const Epi& E, int tid_in) {
    int tid_ = tid_in; asm volatile("" : "+v"(tid_));
    const int tid = tid_, wid = __builtin_amdgcn_readfirstlane(tid >> 6), lane = tid & 63, wr = wid >> 2, wc = wid & 3, fr = lane & 15, fq = lane >> 4;
    const int K = g.ld, nt = g.K / BK;
    unsigned voffA[2], voffB[2];
#pragma unroll
    for (int i = 0; i < 2; ++i) { int R, C; stage_rc(tid * 16 + i * 8192, R, C); const int Rb = Epi::PERM ? ((R & ~31) + perm32(R & 31)) : R;
        voffA[i] = (unsigned)(R * K + C) * 2u; voffB[i] = (unsigned)(Rb * K + C) * 2u; }
    const size_t kstep = (size_t)(BK * 2);
    const size_t hstep = (size_t)HALF * K * 2;
    const size_t tstep = 2 * hstep;
    const unsigned ldsw = (unsigned)wid * 1024u;
    const int aoff = lds_byte(wr * 64 + fr, fq * 8), boff = lds_byte(wc * 32 + fr, fq * 8);
#define PG8_SA(b, h) (((b) * 2 + (h)) * HTB)
#define PG8_SB(b, h) ((4 + (b) * 2 + (h)) * HTB)
#define PG8_STAGE(bufoff, gbase, voff) do { _Pragma("unroll") for (int _i = 0; _i < 2; ++_i) \
        __builtin_amdgcn_global_load_lds((const unsigned*)((const char*)(gbase) + (voff)[_i]), (PG8_LAS unsigned*)(lds + (bufoff) + ldsw + _i * 8192), 16, 0, 0); } while (0)
#define PG8_LDA(dst, b, h) do { _Pragma("unroll") for (int m = 0; m < 4; ++m) _Pragma("unroll") for (int k = 0; k < 2; ++k) dst[m][k] = *(const PG8_LAS bf16x8*)(lds + PG8_SA(b, h) + aoff + m * 2048 + k * 1024); } while (0)
#define PG8_LDB(dst, b, h) do { _Pragma("unroll") for (int n = 0; n < 2; ++n) _Pragma("unroll") for (int k = 0; k < 2; ++k) dst[n][k] = *(const PG8_LAS bf16x8*)(lds + PG8_SB(b, h) + boff + n * 2048 + k * 1024); } while (0)
#define PG8_MMA(ai, bj, At, Bt) do { __builtin_amdgcn_s_setprio(1); _Pragma("unroll") for (int m = 0; m < 4; ++m) _Pragma("unroll") for (int n = 0; n < 2; ++n) _Pragma("unroll") for (int k = 0; k < 2; ++k) \
        acc[ai][bj][m][n] = __builtin_amdgcn_mfma_f32_16x16x32_bf16(Bt[n][k], At[m][k], acc[ai][bj][m][n], 0, 0, 0); __builtin_amdgcn_s_setprio(0); } while (0)
#define PG8_WAIT_V(n) asm volatile("s_waitcnt vmcnt(" #n ")" ::: "memory")
#define PG8_WAIT_L(n) asm volatile("s_waitcnt lgkmcnt(" #n ")" ::: "memory")
#define PG8_BAR __builtin_amdgcn_s_barrier()
#define PG8_SCHED __builtin_amdgcn_sched_barrier(0)
    Unit cur, nxt; int ui = 0;
    if (!S.next(0, cur)) return;
    f32x4 acc[2][2][4][2];
#pragma unroll
    for (int a = 0; a < 2; ++a)
#pragma unroll
        for (int b = 0; b < 2; ++b)
#pragma unroll
            for (int m = 0; m < 4; ++m)
#pragma unroll
                for (int n = 0; n < 2; ++n) acc[a][b][m][n] = (f32x4){0.f, 0.f, 0.f, 0.f};
    bf16x8 At[4][2], B0[2][2], B1[2][2];
#define PG8_UA(u) ((const char*)g.A + (size_t)((u).pm % g.mt) * tstep + (size_t)((u).pm / g.mt) * (size_t)g.ksl * 2)
#define PG8_UB(u) ((const char*)g.Bt + (size_t)(u).pn * tstep + (size_t)((u).pm / g.mt) * (size_t)g.ksl * 2)
    const char* cA = PG8_UA(cur); const char* cB = PG8_UB(cur);
    S.a_ready(cur);
    if constexpr (SP2) {
        PG8_STAGE(PG8_SB(0, 0), cB, voffB); PG8_STAGE(PG8_SB(0, 1), cB + hstep, voffB); PG8_STAGE(PG8_SA(0, 0), cA, voffA); PG8_STAGE(PG8_SA(0, 1), cA + hstep, voffA);
        if (wr == 1) PG8_BAR;
        PG8_WAIT_V(2); PG8_BAR;
        PG8_STAGE(PG8_SB(1, 0), cB + kstep, voffB); PG8_STAGE(PG8_SA(1, 0), cA + kstep, voffA); PG8_STAGE(PG8_SB(1, 1), cB + hstep + kstep, voffB);
        PG8_WAIT_V(6); PG8_BAR;
    } else {
        PG8_STAGE(PG8_SB(0, 0), cB, voffB); PG8_STAGE(PG8_SA(0, 0), cA, voffA); PG8_STAGE(PG8_SB(0, 1), cB + hstep, voffB); PG8_STAGE(PG8_SA(0, 1), cA + hstep, voffA);
        if (wr == 1) PG8_BAR;
        PG8_WAIT_V(4); PG8_BAR;
        PG8_STAGE(PG8_SB(1, 0), cB + kstep, voffB); PG8_STAGE(PG8_SA(1, 0), cA + kstep, voffA); PG8_STAGE(PG8_SB(1, 1), cB + hstep + kstep, voffB);
        PG8_WAIT_V(6); PG8_BAR;
    }
    for (;;) {
        const bool has_next = S.next(ui + 1, nxt);
        const char* nA = has_next ? PG8_UA(nxt) : cA; const char* nB = has_next ? PG8_UB(nxt) : cB;
        for (int t = 0; t < nt; t += 2) {
            const bool last = (t == nt - 2);
            const char* a1 = cA + (size_t)(t + 1) * kstep;
            const char* a2 = last ? nA : cA + (size_t)(t + 2) * kstep; const char* b2 = last ? nB : cB + (size_t)(t + 2) * kstep;
            const char* a3 = a2 + kstep; const char* b3 = b2 + kstep;
            if (last && has_next) S.a_ready(nxt);
            if constexpr (SP2) {
            PG8_LDB(B0, 0, 0); PG8_LDB(B1, 0, 1); PG8_SCHED; PG8_LDA(At, 0, 0); PG8_STAGE(PG8_SA(1, 1), a1 + hstep, voffA);
            PG8_WAIT_V(8); PG8_WAIT_L(0); PG8_BAR; PG8_MMA(0, 0, At, B0); PG8_MMA(0, 1, At, B1); PG8_BAR; PG8_SCHED;
            PG8_LDA(At, 0, 1); PG8_STAGE(PG8_SB(0, 0), b2, voffB); PG8_STAGE(PG8_SB(0, 1), b2 + hstep, voffB); PG8_STAGE(PG8_SA(0, 0), a2, voffA);
            PG8_WAIT_V(8); PG8_WAIT_L(0); PG8_BAR; PG8_MMA(1, 0, At, B0); PG8_MMA(1, 1, At, B1); PG8_BAR; PG8_SCHED;
            PG8_LDB(B0, 1, 0); PG8_LDB(B1, 1, 1); PG8_SCHED; PG8_LDA(At, 1, 0); PG8_STAGE(PG8_SA(0, 1), a2 + hstep, voffA);
            PG8_WAIT_V(8); PG8_WAIT_L(0); PG8_BAR; PG8_MMA(0, 0, At, B0); PG8_MMA(0, 1, At, B1); PG8_BAR; PG8_SCHED;
            PG8_LDA(At, 1, 1); PG8_STAGE(PG8_SB(1, 0), b3, voffB); PG8_STAGE(PG8_SB(1, 1), b3 + hstep, voffB); PG8_STAGE(PG8_SA(1, 0), a3, voffA);
            PG8_WAIT_V(8); PG8_WAIT_L(0); PG8_BAR; PG8_MMA(1, 0, At, B0); PG8_MMA(1, 1, At, B1); PG8_BAR; PG8_SCHED;
            } else {
            PG8_LDB(B0, 0, 0); PG8_SCHED; PG8_LDA(At, 0, 0); PG8_STAGE(PG8_SA(1, 1), a1 + hstep, voffA);
            PG8_WAIT_L(8); PG8_BAR; PG8_WAIT_L(0); PG8_MMA(0, 0, At, B0); PG8_BAR; PG8_SCHED;
            PG8_LDB(B1, 0, 1); PG8_STAGE(PG8_SB(0, 0), b2, voffB);
            PG8_BAR; PG8_WAIT_L(0); PG8_MMA(0, 1, At, B1); PG8_BAR;
            PG8_LDA(At, 0, 1); PG8_STAGE(PG8_SA(0, 0), a2, voffA);
            PG8_BAR; PG8_WAIT_L(0); PG8_MMA(1, 0, At, B0); PG8_BAR; PG8_SCHED;
            PG8_STAGE(PG8_SB(0, 1), b2 + hstep, voffB);
            PG8_WAIT_V(6); PG8_BAR; PG8_MMA(1, 1, At, B1); PG8_BAR;
            PG8_LDB(B0, 1, 0); PG8_SCHED; PG8_LDA(At, 1, 0); PG8_STAGE(PG8_SA(0, 1), a2 + hstep, voffA);
            PG8_WAIT_L(8); PG8_BAR; PG8_WAIT_L(0); PG8_MMA(0, 0, At, B0); PG8_BAR; PG8_SCHED;
            PG8_LDB(B1, 1, 1); PG8_STAGE(PG8_SB(1, 0), b3, voffB);
            PG8_BAR; PG8_WAIT_L(0); PG8_MMA(0, 1, At, B1); PG8_BAR;
            PG8_LDA(At, 1, 1); PG8_STAGE(PG8_SA(1, 0), a3, voffA);
            PG8_BAR; PG8_WAIT_L(0); PG8_MMA(1, 0, At, B0); PG8_BAR; PG8_SCHED;
            PG8_STAGE(PG8_SB(1, 1), b3 + hstep, voffB);
            PG8_WAIT_V(6); PG8_BAR; PG8_MMA(1, 1, At, B1); PG8_BAR;
            }
        }
        if constexpr (ALIGN_EPI) { if (wr == 0) PG8_BAR; }
        if constexpr (!Epi::AFTER_DRAIN) { E(acc, cur, wr, wc, fr, fq); S.done(cur); }
        if (!has_next) break;
#pragma unroll
        for (int a = 0; a < 2; ++a)
#pragma unroll
            for (int b = 0; b < 2; ++b)
#pragma unroll
                for (int m = 0; m < 4; ++m)
#pragma unroll
                    for (int n = 0; n < 2; ++n) acc[a][b][m][n] = (f32x4){0.f, 0.f, 0.f, 0.f};
        cur = nxt; cA = nA; cB = nB; ++ui;
        if constexpr (ALIGN_EPI) { if (wr == 1) PG8_BAR; }
    }
    PG8_WAIT_V(0);
    if constexpr (!ALIGN_EPI) { if (wr == 0) PG8_BAR; }
    PG8_BAR;
    if constexpr (Epi::AFTER_DRAIN) { E.fused(acc, cur, wr, wc, fr, fq, lds, wid, lane); S.done(cur); }
#undef PG8_SA
#undef PG8_SB
#undef PG8_STAGE
#undef PG8_LDA
#undef PG8_LDB
#undef PG8_MMA
#undef PG8_WAIT_V
#undef PG8_WAIT_L
#undef PG8_BAR
#undef PG8_SCHED
}
}


using pg8::bf16_t; using pg8::bf16x8; using pg8::f32x4; using pg8::u32x4;
typedef unsigned u32x2 __attribute__((ext_vector_type(2)));
typedef short bf16x4 __attribute__((ext_vector_type(4)));
#define LAS PG8_LAS

constexpr int NT = 512;
constexpr int MP = 16384, MS = 512, MT = MP + MS;
constexpr int DM = 2048, FF = 5632, NGU = 2 * FF;
constexpr int INA = 6680, INA_P = 6912, LOGC = 6144, QMA = 6168;
constexpr int NKV = 3072, INB = 2048;
constexpr int NITEM = 264 * 12;
constexpr float EPSF = 1e-6f;
constexpr float LOG2E = 1.4426950408889634f;
constexpr float LAM0 = 0.35550906759f;

constexpr size_t O_Y = 0;
constexpr size_t O_DELTA_P = (size_t)MT * DM;
constexpr size_t O_CONV_P = O_DELTA_P + 12 * 128 * 128;
constexpr size_t O_K_P = O_CONV_P + 3 * 4608;
constexpr size_t O_V_P = O_K_P + (size_t)MP * 1536;
constexpr size_t O_MK_P = O_V_P + (size_t)MP * 1536;
constexpr size_t O_MV_P = O_MK_P + 2 * 256 * 512;
constexpr size_t O_DELTA_S = O_MV_P + 2 * 256 * 512;
constexpr size_t O_CONV_S = O_DELTA_S + 8 * 12 * 128 * 128;
constexpr size_t O_K_S = O_CONV_S + 8 * 3 * 4608;
constexpr size_t O_V_S = O_K_S + (size_t)MS * 1536;

constexpr size_t AL(size_t x) { return (x + 4095) & ~(size_t)4095; }
constexpr size_t SZ_WGU = (size_t)NGU * DM * 2, SZ_WDN = (size_t)DM * FF * 2, SZ_WSQ = (size_t)DM * DM * 2;
constexpr size_t W_GU = 0;
constexpr size_t W_DN = W_GU + 4 * SZ_WGU;
constexpr size_t W_INA = W_DN + 4 * SZ_WDN;
constexpr size_t W_OUT = W_INA + (size_t)INA_P * DM * 2;
constexpr size_t W_KV = W_OUT + 2 * SZ_WSQ;
constexpr size_t W_INB = W_KV + (size_t)NKV * DM * 2;
constexpr size_t W_MEM = W_INB + SZ_WSQ;
constexpr size_t B_XN = W_MEM + 2 * (size_t)1024 * DM * 2;
constexpr size_t B_MIX = B_XN + (size_t)MT * DM * 2;
constexpr size_t B_R1 = B_MIX + (size_t)MT * DM * 2;
constexpr size_t SZ_R = (size_t)MT * INA_P * 2;
constexpr size_t B_R2 = B_R1 + SZ_R;
constexpr size_t B_O = B_R2 + SZ_R;
constexpr size_t B_LOG = B_O + (size_t)MT * 1536 * 4;
constexpr size_t B_GL = B_LOG + AL((size_t)MT * 24 * 4);
constexpr size_t B_KP = B_GL + AL((size_t)NITEM * 4);
constexpr size_t B_VTP = B_KP + (size_t)MP * 1536 * 2;
constexpr size_t B_KS = B_VTP + (size_t)MP * 1536 * 2;
constexpr size_t B_VTS = B_KS + (size_t)8 * 1088 * 1536 * 2;
constexpr size_t B_MEMN = B_VTS + (size_t)8 * 1088 * 1536 * 2;
constexpr size_t B_MK = B_MEMN + (size_t)2 * 256 * DM * 2;
constexpr size_t B_MVT = B_MK + (size_t)2 * 9 * 4 * 256 * 128 * 2;
constexpr size_t B_DP = B_MVT + (size_t)2 * 9 * 4 * 256 * 128 * 2;
constexpr size_t B_BAR = B_DP + (size_t)11 * 512 * DM * 4;
constexpr size_t WS_END = B_BAR + 16384;
constexpr size_t G_UT = 0, G_W = (size_t)NITEM * 8192, G_QG = 2 * G_W, G_KDT = 3 * G_W, G_A = 4 * G_W;

constexpr int LDS_BYTES = 147456;

struct Args { const float* in[26]; float* out; unsigned char* ws; int ph_lo, ph_hi, repmask, pad; };

__device__ __forceinline__ unsigned pk2(float lo, float hi) { unsigned r; asm volatile("v_cvt_pk_bf16_f32 %0, %1, %2" : "=v"(r) : "v"(lo), "v"(hi)); return r; }
__device__ __forceinline__ bf16_t f2bf(float f) { return (bf16_t)(pk2(f, 0.f) & 0xffffu); }
__device__ __forceinline__ float bf2f(bf16_t b) { return __uint_as_float(((unsigned)b) << 16); }
__device__ __forceinline__ float shx(float v, int mask, int lane) { return __int_as_float(__builtin_amdgcn_ds_bpermute((lane ^ mask) << 2, __float_as_int(v))); }
__device__ __forceinline__ float wave_sum(float v, int lane) {
#pragma unroll
    for (int o = 1; o < 64; o <<= 1) v += shx(v, o, lane);
    return v;
}
__device__ __forceinline__ float siluf(float x) { return x * __builtin_amdgcn_rcpf(1.f + __expf(-x)); }
__device__ __forceinline__ const float* xrow(const Args& a, int r) { return r < MP ? a.in[0] + (size_t)r * DM : a.in[1] + (size_t)(r - MP) * DM; }

struct EpiBase { int mode; float* f0; float* f1; bf16_t* b0; bf16_t* b1; int ldc; };
struct EpiF32G : EpiBase {
    static constexpr bool PERM = true, AFTER_DRAIN = false;
    __device__ __forceinline__ void operator()(const f32x4 (&acc)[2][2][4][2], const pg8::Unit& u, int wr, int wc, int fr, int fq) const {
        const int rl = wr * 64 + fr, cl = wc * 32 + 8 * fq;
        float* C; int ld;
        if (mode == 0) { C = f0 + (size_t)u.pm * 256 * ldc + u.pn * 256; ld = ldc; }
        else if (mode == 3) { const bool isv = u.pn >= 6, pr = u.pm < 64; ld = 1536;
            C = f0 + (pr ? (isv ? O_V_P : O_K_P) + (size_t)u.pm * 256 * 1536 : (isv ? O_V_S : O_K_S) + (size_t)(u.pm - 64) * 256 * 1536) + (isv ? u.pn - 6 : u.pn) * 256; }
        else { ld = 512; C = u.pn < 2 ? f0 + u.pn * 256 : f1 + (u.pn - 2) * 256; }
#pragma unroll
        for (int ai = 0; ai < 2; ++ai)
#pragma unroll
            for (int m = 0; m < 4; ++m) { float* rowp = C + (size_t)(rl + ai * 128 + m * 16) * ld + cl;
#pragma unroll
                for (int bj = 0; bj < 2; ++bj)
#pragma unroll
                    for (int n = 0; n < 2; ++n) *(f32x4*)(rowp + bj * 128 + n * 4) = acc[ai][bj][m][n]; }
    }
};
struct EpiSwigluG : EpiBase {
    static constexpr bool PERM = true, AFTER_DRAIN = false;
    __device__ __forceinline__ void operator()(const f32x4 (&acc)[2][2][4][2], const pg8::Unit& u, int wr, int wc, int fr, int fq) const {
        const int rl = wr * 64 + fr, cl = wc * 32 + 8 * fq;
        bf16_t* O = b0 + (size_t)u.pm * 256 * FF + u.pn * 128;
#pragma unroll
        for (int ai = 0; ai < 2; ++ai)
#pragma unroll
            for (int m = 0; m < 4; ++m) {
                float v[8];
#pragma unroll
                for (int n = 0; n < 2; ++n)
#pragma unroll
                    for (int j = 0; j < 4; ++j) { const float g = acc[ai][0][m][n][j], up = acc[ai][1][m][n][j]; v[n * 4 + j] = g * up * __builtin_amdgcn_rcpf(1.f + __expf(-g)); }
                u32x4 w; w.x = pk2(v[0], v[1]); w.y = pk2(v[2], v[3]); w.z = pk2(v[4], v[5]); w.w = pk2(v[6], v[7]);
                *(u32x4*)(O + (size_t)(rl + ai * 128 + m * 16) * FF + cl) = w; }
    }
};
struct EpiBf16G : EpiBase {
    static constexpr bool PERM = true, AFTER_DRAIN = false;
    __device__ __forceinline__ void operator()(const f32x4 (&acc)[2][2][4][2], const pg8::Unit& u, int wr, int wc, int fr, int fq) const {
        const int rl = wr * 64 + fr, cl = wc * 32 + 8 * fq;
        bf16_t* O = b0 + (size_t)u.pm * 256 * ldc + u.pn * 256;
#pragma unroll
        for (int ai = 0; ai < 2; ++ai)
#pragma unroll
            for (int m = 0; m < 4; ++m) { const int r = rl + ai * 128 + m * 16;
#pragma unroll
                for (int bj = 0; bj < 2; ++bj) { const f32x4 v0 = acc[ai][bj][m][0], v1 = acc[ai][bj][m][1]; const int c = cl + bj * 128;
                    u32x4 w; w.x = pk2(v0[0], v0[1]); w.y = pk2(v0[2], v0[3]); w.z = pk2(v1[0], v1[1]); w.w = pk2(v1[2], v1[3]);
                    *(u32x4*)(O + (size_t)r * ldc + c) = w;
                    const int cg = u.pn * 256 + c;
                    if (f0 && cg >= LOGC && cg < LOGC + 24) { float* lp = f0 + (size_t)(u.pm * 256 + r) * 24 + (cg - LOGC); *(f32x4*)lp = v0; *(f32x4*)(lp + 4) = v1; } } }
    }
};

template <int MODE>
__device__ __forceinline__ void conv_weight(const float* W, int K, int N, int NP, bf16_t* WT, float* scr, int gw, int ngw, int lane, int ldd = 0) {
    if (ldd == 0) ldd = K;
    const int nblk = NP / 32, nitems = (K / 64) * nblk;
    for (int it = gw; it < nitems; it += ngw) {
        const int kb = it / nblk, nb = it % nblk, k0 = 64 * kb, n0 = 32 * nb;
        const int n = n0 + (lane & 31); const bool ok = n < N;
        float wv[32];
#pragma unroll
        for (int i = 0; i < 32; ++i) wv[i] = ok ? W[(size_t)(k0 + 2 * i + (lane >> 5)) * N + n] : 0.f;
#pragma unroll
        for (int i = 0; i < 32; ++i) scr[(2 * i + (lane >> 5)) * 33 + (lane & 31)] = wv[i];
        asm volatile("s_waitcnt lgkmcnt(0)" ::: "memory");
        int drow0 = n0;
        if (MODE == 1) { const int half = n0 >= FF ? 1 : 0, j = n0 - half * FF; drow0 = 256 * (j >> 7) + 128 * half + (j & 127); }
        const int c = lane & 7;
#pragma unroll
        for (int j = 0; j < 4; ++j) { const int nn = (lane >> 3) + 8 * j; const float* s = scr + (8 * c) * 33 + nn;
            u32x4 o; o.x = pk2(s[0], s[33]); o.y = pk2(s[2 * 33], s[3 * 33]); o.z = pk2(s[4 * 33], s[5 * 33]); o.w = pk2(s[6 * 33], s[7 * 33]);
            *(u32x4*)(WT + (size_t)(drow0 + nn) * ldd + k0 + 8 * c) = o; }
        asm volatile("s_waitcnt lgkmcnt(0)" ::: "memory");
    }
}

__device__ __forceinline__ void row_update(const float* hin, float* hout, const float* d, float coef, const float* g1, const float* g2, bf16_t* xn, const float* g3, bf16_t* kvn, int lane, int nd = 1, size_t dstride = 0, const bf16_t* dbf = nullptr) {
    f32x4 h[8];
#pragma unroll
    for (int j = 0; j < 8; ++j) h[j] = *(const f32x4*)(hin + 4 * (lane + 64 * j));
    if (d || dbf) {
        f32x4 dv[8]; float ss = 0.f;
        if (dbf) {
#pragma unroll
            for (int j = 0; j < 8; ++j) { const u32x2 w = *(const u32x2*)(dbf + 4 * (lane + 64 * j)); dv[j] = (f32x4){__uint_as_float(w.x << 16), __uint_as_float(w.x & 0xffff0000u), __uint_as_float(w.y << 16), __uint_as_float(w.y & 0xffff0000u)}; }
        } else {
#pragma unroll
            for (int j = 0; j < 8; ++j) dv[j] = *(const f32x4*)(d + 4 * (lane + 64 * j));
        }
        for (int s = 1; s < nd; ++s) {
#pragma unroll
            for (int j = 0; j < 8; ++j) dv[j] += *(const f32x4*)(d + (size_t)s * dstride + 4 * (lane + 64 * j)); }
#pragma unroll
        for (int j = 0; j < 8; ++j) { ss += (dv[j].x * dv[j].x + dv[j].y * dv[j].y) + (dv[j].z * dv[j].z + dv[j].w * dv[j].w); }
        const float rs = coef * rsqrtf(wave_sum(ss, lane) * (1.f / DM) + EPSF);
#pragma unroll
        for (int j = 0; j < 8; ++j) { const f32x4 g = *(const f32x4*)(g1 + 4 * (lane + 64 * j)); h[j] += dv[j] * g * rs; }
    }
    if (hout) {
#pragma unroll
        for (int j = 0; j < 8; ++j) *(f32x4*)(hout + 4 * (lane + 64 * j)) = h[j];
    }
    if (g2) {
        float ss = 0.f;
#pragma unroll
        for (int j = 0; j < 8; ++j) ss += (h[j].x * h[j].x + h[j].y * h[j].y) + (h[j].z * h[j].z + h[j].w * h[j].w);
        const float rs = rsqrtf(wave_sum(ss, lane) * (1.f / DM) + EPSF);
#pragma unroll
        for (int j = 0; j < 8; ++j) { const f32x4 g = *(const f32x4*)(g2 + 4 * (lane + 64 * j)); const f32x4 o = h[j] * g * rs;
            u32x2 w; w.x = pk2(o.x, o.y); w.y = pk2(o.z, o.w); *(u32x2*)(xn + 4 * (lane + 64 * j)) = w; }
        if (g3) {
#pragma unroll
            for (int j = 0; j < 8; ++j) { const f32x4 g = *(const f32x4*)(g3 + 4 * (lane + 64 * j)); const f32x4 o = h[j] * g * rs;
                u32x2 w; w.x = pk2(o.x, o.y); w.y = pk2(o.z, o.w); *(u32x2*)(kvn + 4 * (lane + 64 * j)) = w; }
        }
    }
}

__device__ __forceinline__ void phase_rowpass(const Args& a, const float* D, float coef, const float* g1, const float* g2, const float* g3, int gw, int ngw, int lane, int ks) {
    float* H = a.out; bf16_t* XN = (bf16_t*)(a.ws + B_XN); bf16_t* KVN = (bf16_t*)(a.ws + B_MIX); const float* DP = (const float*)(a.ws + B_DP);
    for (int r = gw; r < MT; r += ngw) {
        if (r < MP) row_update(H + (size_t)r * DM, H + (size_t)r * DM, nullptr, coef, g1, g2, XN + (size_t)r * DM, g3, KVN + (size_t)r * DM, lane, 1, 0, (const bf16_t*)D + (size_t)r * DM);
        else row_update(H + (size_t)r * DM, H + (size_t)r * DM, DP + (size_t)(r - MP) * DM, coef, g1, g2, XN + (size_t)r * DM, g3, KVN + (size_t)r * DM, lane, ks, (size_t)512 * DM);
    }
}

constexpr int GP_ROW = 136;
constexpr int GP_L = 0;
constexpr int GP_SC = 64 * 68 * 4;
constexpr int GP_TS = 64 * GP_ROW * 2;
constexpr int GP_QH = GP_SC + 4096, GP_QL = GP_QH + GP_TS, GP_KH = GP_QL + GP_TS, GP_KL = GP_KH + GP_TS;
__device__ __forceinline__ void gdn_prep_item(unsigned char* lds, const Args& a, int cidx, int h, int tid_in) {
    int tid_ = tid_in; asm volatile("" : "+v"(tid_));
    const int tid = tid_, lane = tid & 63, wid = tid >> 6;
    const bf16_t* PROJ = (const bf16_t*)(a.ws + B_R1);
    const float* LOG = (const float*)(a.ws + B_LOG);
    bf16_t* GI = (bf16_t*)(a.ws + B_R2);
    const int item = cidx * 12 + h;
    const int row0 = cidx < 256 ? cidx * 64 : MP + (cidx - 256) * 64;
    unsigned sb_ = GP_SC; asm volatile("" : "+v"(sb_));
    float* sc = (float*)(lds + sb_);
    float* sBeta = sc, *sGc = sc + 64, *sEg = sc + 128, *sEd = sc + 192, *sPart = sc + 256;
    float v[64];
#pragma unroll
    for (int r = 0; r < 64; ++r) v[r] = 0.f;
    const int role = tid >> 7, c = tid & 127;
    if (tid < 384) {
        const int ch = role * 1536 + h * 128 + c;
        const float* cw = a.in[16];
        const float w0 = cw[ch], w1 = cw[4608 + ch], w2 = cw[2 * 4608 + ch], w3 = cw[3 * 4608 + ch];
        float x0, x1, x2;
        if (cidx >= 256) { const float* sb = a.in[8] + (size_t)(cidx - 256) * 3 * 4608 + ch; x0 = sb[0]; x1 = sb[4608]; x2 = sb[2 * 4608]; }
        else if (cidx == 0) { x0 = x1 = x2 = 0.f; }
        else { const bf16_t* pb = PROJ + (size_t)(row0 - 3) * INA_P + ch; x0 = bf2f(pb[0]); x1 = bf2f(pb[INA_P]); x2 = bf2f(pb[2 * INA_P]); }
        const bf16_t* px = PROJ + (size_t)row0 * INA_P + ch; unsigned poff = 0;
#pragma unroll
        for (int r = 0; r < 64; ++r) { v[r] = bf2f(*(const bf16_t*)((const char*)px + poff)); poff += INA_P * 2; asm volatile("" : "+v"(poff)); }
#pragma unroll
        for (int r = 63; r >= 0; --r) { const float xm1 = r >= 1 ? v[r >= 1 ? r - 1 : 0] : x2, xm2 = r >= 2 ? v[r >= 2 ? r - 2 : 0] : (r == 1 ? x2 : x1), xm3 = r >= 3 ? v[r >= 3 ? r - 3 : 0] : (r == 2 ? x2 : (r == 1 ? x1 : x0));
            v[r] = siluf(w0 * xm3 + w1 * xm2 + w2 * xm1 + w3 * v[r]); }
        if (role < 2) {
            float t[64];
#pragma unroll
            for (int r = 0; r < 64; ++r) t[r] = v[r] * v[r];
#define BFLY(N, M) do { const bool up = lane & (M); \
                _Pragma("unroll") for (int c0 = 0; c0 < (N); c0 += 16) { float snd_[16], rcv_[16]; \
                _Pragma("unroll") for (int i = 0; i < 16; ++i) if (c0 + i < (N)) { snd_[i] = up ? t[c0 + i] : t[c0 + i + (N)]; t[c0 + i] = up ? t[c0 + i + (N)] : t[c0 + i]; } \
                _Pragma("unroll") for (int i = 0; i < 16; ++i) if (c0 + i < (N)) rcv_[i] = shx(snd_[i], (M), lane); \
                _Pragma("unroll") for (int i = 0; i < 16; ++i) if (c0 + i < (N)) t[c0 + i] += rcv_[i]; } } while (0)
            BFLY(32, 32); BFLY(16, 16); BFLY(8, 8); BFLY(4, 4); BFLY(2, 2); BFLY(1, 1);
            sPart[(role * 2 + (wid & 1)) * 64 + lane] = t[0];
        }
    } else if (wid == 6) {
        const float bl = LOG[(size_t)(row0 + lane) * 24 + h], al = LOG[(size_t)(row0 + lane) * 24 + 12 + h];
        const float beta = 1.f / (1.f + __expf(-bl));
        const float xx = al + a.in[18][h];
        const float sp = xx > 20.f ? xx : __logf(1.f + __expf(xx));
        float g = -__expf(a.in[17][h]) * sp;
#pragma unroll
        for (int o = 1; o < 64; o <<= 1) { const float t = __int_as_float(__builtin_amdgcn_ds_bpermute((lane - o) << 2, __float_as_int(g))); if (lane >= o) g += t; }
        const float gl = __int_as_float(__builtin_amdgcn_readlane(__float_as_int(g), 63));
        sBeta[lane] = beta; sGc[lane] = g; sEg[lane] = __expf(g); sEd[lane] = __expf(gl - g);
        if (lane == 0) ((float*)(a.ws + B_GL))[item] = __expf(gl);
    }
    __syncthreads();
    if (wid == 7) {
        sc[512 + lane] = rsqrtf(sPart[lane] + sPart[64 + lane] + EPSF) * 0.08838834764831845f;
        sc[576 + lane] = rsqrtf(sPart[128 + lane] + sPart[192 + lane] + EPSF);
        sc[640 + lane] = sBeta[lane] * sEg[lane];
    }
    __syncthreads();
    if (tid < 384) {
        const f32x4* sc4 = (const f32x4*)sc;
        if (role == 0) {
            unsigned qh_ = GP_QH + c * 2; asm volatile("" : "+v"(qh_)); unsigned char* QH = lds + qh_; bf16_t* QG = GI + G_QG + (size_t)item * 8192 + c; unsigned qoff = 0;
#pragma unroll
            for (int hf = 0; hf < 2; ++hf) {
                f32x4 iq[8], eg[8];
#pragma unroll
                for (int g4 = 0; g4 < 8; ++g4) { iq[g4] = sc4[128 + hf * 8 + g4]; eg[g4] = sc4[32 + hf * 8 + g4]; }
                __builtin_amdgcn_sched_barrier(0);
#pragma unroll
                for (int rr = 0; rr < 32; ++rr) { const int r = hf * 32 + rr; const float q = v[r] * iq[rr >> 2][rr & 3];
                    const bf16_t hi = f2bf(q); *(bf16_t*)(QH + r * GP_ROW * 2) = hi; *(bf16_t*)(QH + GP_TS + r * GP_ROW * 2) = f2bf(q - bf2f(hi)); *(bf16_t*)((char*)QG + qoff) = f2bf(q * eg[rr >> 2][rr & 3]); qoff += 256; asm volatile("" : "+v"(qoff)); }
            }
        } else if (role == 1) {
            unsigned kh_ = GP_KH + c * 2; asm volatile("" : "+v"(kh_)); unsigned char* KH = lds + kh_; bf16_t* KDT = GI + G_KDT + (size_t)item * 8192 + (size_t)c * 64;
#pragma unroll
            for (int hf = 0; hf < 2; ++hf) {
                f32x4 ik[8], ed[8], be[8];
#pragma unroll
                for (int g4 = 0; g4 < 8; ++g4) { ik[g4] = sc4[144 + hf * 8 + g4]; ed[g4] = sc4[48 + hf * 8 + g4]; be[g4] = sc4[160 + hf * 8 + g4]; }
                __builtin_amdgcn_sched_barrier(0);
#pragma unroll
                for (int r8 = 0; r8 < 4; ++r8) { float kd[8];
#pragma unroll
                    for (int i = 0; i < 8; ++i) { const int rr = r8 * 8 + i, r = hf * 32 + rr; const float k = v[r] * ik[rr >> 2][rr & 3];
                        const bf16_t hi = f2bf(k); *(bf16_t*)(KH + r * GP_ROW * 2) = hi; *(bf16_t*)(KH + GP_TS + r * GP_ROW * 2) = f2bf(k - bf2f(hi)); kd[i] = k * ed[rr >> 2][rr & 3]; v[r] = k * be[rr >> 2][rr & 3]; }
                    u32x4 w; w.x = pk2(kd[0], kd[1]); w.y = pk2(kd[2], kd[3]); w.z = pk2(kd[4], kd[5]); w.w = pk2(kd[6], kd[7]);
                    *(u32x4*)(KDT + (hf * 4 + r8) * 8) = w; }
            }
        } else {
            f32x4 bt[16];
#pragma unroll
            for (int g4 = 0; g4 < 16; ++g4) bt[g4] = sc4[g4];
            __builtin_amdgcn_sched_barrier(0);
#pragma unroll
            for (int r = 0; r < 64; ++r) v[r] *= bt[r >> 2][r & 3];
        }
    }
    __syncthreads();
    {
        const int fr = lane & 15, fq = lane >> 4, mat = wid >> 2, mt = wid & 3;
        unsigned xo_ = (mat ? GP_QH : GP_KH) + (fr * GP_ROW + fq * 8) * 2, ko_ = GP_KH + (fr * GP_ROW + fq * 8) * 2, lo_ = GP_L; asm volatile("" : "+v"(xo_), "+v"(ko_), "+v"(lo_));
        const unsigned char* XH = lds + xo_; const unsigned char* XL = XH + GP_TS;
        const unsigned char* KH = lds + ko_; const unsigned char* KL = KH + GP_TS;
        float* Ls = (float*)(lds + lo_); bf16_t* AM = GI + G_A + (size_t)item * 4096;
        bf16x8 xh[4], xl[4];
#pragma unroll
        for (int ks = 0; ks < 4; ++ks) { const int off = (mt * 16 * GP_ROW + ks * 32) * 2; xh[ks] = *(const bf16x8*)(XH + off); xl[ks] = *(const bf16x8*)(XL + off); }
#pragma unroll
        for (int nt = 0; nt < 4; ++nt) {
            f32x4 acc = {0.f, 0.f, 0.f, 0.f};
#pragma unroll
            for (int ks = 0; ks < 4; ++ks) { const int off = (nt * 16 * GP_ROW + ks * 32) * 2; const bf16x8 kh = *(const bf16x8*)(KH + off), kl = *(const bf16x8*)(KL + off);
                acc = __builtin_amdgcn_mfma_f32_16x16x32_bf16(xh[ks], kh, acc, 0, 0, 0);
                acc = __builtin_amdgcn_mfma_f32_16x16x32_bf16(xh[ks], kl, acc, 0, 0, 0);
                acc = __builtin_amdgcn_mfma_f32_16x16x32_bf16(xl[ks], kh, acc, 0, 0, 0); }
            const int jj = nt * 16 + fr; const float gj = sGc[jj];
#pragma unroll
            for (int j = 0; j < 4; ++j) { const int i = mt * 16 + fq * 4 + j; const float gi = sGc[i];
                const float dec = __expf(jj <= i ? gi - gj : 0.f);
                if (mat == 0) Ls[i * 68 + jj] = jj < i ? sBeta[i] * acc[j] * dec : 0.f;
                else AM[i * 64 + jj] = f2bf(jj <= i ? acc[j] * dec : 0.f); }
        }
    }
    __syncthreads();
    if (tid >= 128 && tid < 384) {
        unsigned lb_ = GP_L; asm volatile("" : "+v"(lb_));
        const f32x4* L4 = (const f32x4*)(lds + lb_);
#pragma unroll
        for (int jb = 0; jb < 16; ++jb) {
            const int j0 = 4 * jb;
            { const f32x4 d1 = L4[(j0 + 1) * 17 + jb], d2 = L4[(j0 + 2) * 17 + jb], d3 = L4[(j0 + 3) * 17 + jb];
              v[j0 + 1] -= d1.x * v[j0];
              v[j0 + 2] -= d2.x * v[j0] + d2.y * v[j0 + 1];
              v[j0 + 3] -= d3.x * v[j0] + d3.y * v[j0 + 1] + d3.z * v[j0 + 2]; }
#pragma unroll
            for (int i0 = j0 + 4; i0 < 64; i0 += 20) {
                f32x4 l[20];
#pragma unroll
                for (int k = 0; k < 20; ++k) if (i0 + k < 64) l[k] = L4[(i0 + k) * 17 + jb];
                __builtin_amdgcn_sched_barrier(0);
#pragma unroll
                for (int k = 0; k < 20; ++k) if (i0 + k < 64) v[i0 + k] -= (l[k].x * v[j0] + l[k].y * v[j0 + 1]) + (l[k].z * v[j0 + 2] + l[k].w * v[j0 + 3]);
            }
        }
        if (role == 2) { bf16_t* UT = GI + G_UT + (size_t)item * 8192 + (size_t)c * 64;
#pragma unroll
            for (int r8 = 0; r8 < 8; ++r8) { u32x4 w; w.x = pk2(v[r8 * 8], v[r8 * 8 + 1]); w.y = pk2(v[r8 * 8 + 2], v[r8 * 8 + 3]); w.z = pk2(v[r8 * 8 + 4], v[r8 * 8 + 5]); w.w = pk2(v[r8 * 8 + 6], v[r8 * 8 + 7]); *(u32x4*)(UT + r8 * 8) = w; }
        } else { bf16_t* Wm = GI + G_W + (size_t)item * 8192 + c; unsigned woff = 0;
#pragma unroll
            for (int r = 0; r < 64; ++r) { *(bf16_t*)((char*)Wm + woff) = f2bf(v[r]); woff += 256; asm volatile("" : "+v"(woff)); } }
    }
    __syncthreads();
}

constexpr int SC_SLOT = 61696;
constexpr int SC_W = 0, SC_QG = 16384, SC_KD = 32768, SC_A = 49152, SC_U = 57344, SC_GL = 61440;
constexpr int SC_ST = 2 * SC_SLOT;
constexpr int SC_VN = SC_ST + 2 * 32 * 136 * 2;
constexpr int SC_PFD = SC_VN + 32 * 72 * 2;
static_assert(SC_PFD + 256 <= LDS_BYTES - 16, "scan LDS map");
__device__ __forceinline__ void gdn_scan_item(unsigned char* lds, const Args& a, int seq, int h, int es, int tid_in) {
    int tid_ = tid_in; asm volatile("" : "+v"(tid_));
    const int tid = tid_, lane = tid & 63, wid = tid >> 6, fr = lane & 15, fq = lane >> 4, mt = wid & 3, nt = wid >> 2;
    const int widu = __builtin_amdgcn_readfirstlane(wid);
    const bf16_t* GI = (const bf16_t*)(a.ws + B_R2); const float* GL = (const float*)(a.ws + B_GL);
    float* O = (float*)(a.ws + B_O);
    bf16_t* ST = (bf16_t*)(lds + SC_ST); bf16_t* VN = (bf16_t*)(lds + SC_VN);
    const int nsteps = seq == 0 ? 256 : 1, cidx0 = seq == 0 ? 0 : 255 + seq, row00 = seq == 0 ? 0 : MP + (seq - 1) * 64;
    f32x4 S[2];
#pragma unroll
    for (int n = 0; n < 2; ++n) {
        if (seq == 0) S[n] = (f32x4){0.f, 0.f, 0.f, 0.f};
        else { const float* sp = a.in[7] + ((size_t)((seq - 1) * 12 + h) * 128 + wid * 16 + fq * 4) * 128 + es * 32 + n * 16 + fr;
            S[n] = (f32x4){sp[0], sp[128], sp[256], sp[384]}; }
    }
    const char* rp[8]; int rstep[8], sdst[8];
    const size_t item0 = (size_t)(cidx0 * 12 + h);
#pragma unroll
    for (int i = 0; i < 8; ++i) { const int n = widu * 8 + i; const bf16_t* p = GI; int st = 8192, ds = 0;
        if (n < 32) { const int mm = n & 15, row = 4 * mm + (lane >> 4), c16 = (lane & 15) ^ (row & 15); p = GI + (n < 16 ? G_W : G_QG) + row * 128 + c16 * 8; ds = (n < 16 ? SC_W : SC_QG) + mm * 1024; }
        else if (n < 48) { const int mm = n - 32, row = 8 * mm + (lane >> 3), c8 = (lane & 7) ^ ((row >> 1) & 7); p = GI + G_KDT + row * 64 + c8 * 8; ds = SC_KD + mm * 1024; }
        else if (n < 56) { const int mm = n - 48, row = 8 * mm + (lane >> 3), c8 = (lane & 7) ^ ((row >> 1) & 7); p = GI + G_A + row * 64 + c8 * 8; st = 4096; ds = SC_A + mm * 1024; }
        else if (n < 60) { const int mm = n - 56, rl = 8 * mm + (lane >> 3), c8 = (lane & 7) ^ ((rl >> 1) & 7); p = GI + G_UT + (es * 32 + rl) * 64 + c8 * 8; ds = SC_U + mm * 1024; }
        else { p = (const bf16_t*)GL; st = 2; ds = SC_GL; }
        rp[i] = (const char*)p + item0 * (size_t)(st * 2); rstep[i] = 12 * st * 2; sdst[i] = ds; }
#define SCAN_DMA16(i_, slot_) do { __builtin_amdgcn_global_load_lds((const unsigned*)rp[i_], (LAS unsigned*)((LAS unsigned char*)lds + (slot_) * SC_SLOT + sdst[i_]), 16, 0, 0); rp[i_] += rstep[i_]; } while (0)
#define SCAN_ISSUE(slot_) do { if (widu < 7) { _Pragma("unroll") for (int i = 0; i < 8; ++i) SCAN_DMA16(i, slot_); } \
        else { _Pragma("unroll") for (int i = 0; i < 4; ++i) SCAN_DMA16(i, slot_); \
               __builtin_amdgcn_global_load_lds((const unsigned*)rp[4], (LAS unsigned*)((LAS unsigned char*)lds + (slot_) * SC_SLOT + SC_GL), 4, 0, 0); rp[4] += rstep[4]; } } while (0)
#define SCAN_BAR() do { asm volatile("s_waitcnt lgkmcnt(0)" ::: "memory"); __builtin_amdgcn_s_barrier(); asm volatile("" ::: "memory"); } while (0)
    __syncthreads();
#pragma unroll
    for (int n = 0; n < 2; ++n) { u32x2 w; w.x = pk2(S[n][0], S[n][1]); w.y = pk2(S[n][2], S[n][3]); *(u32x2*)(ST + (n * 16 + fr) * 136 + wid * 16 + fq * 4) = w; }
    SCAN_ISSUE(0); if (nsteps > 1) SCAN_ISSUE(1);
    float* opv = O; f32x4 ocv = {0.f, 0.f, 0.f, 0.f};
    for (int s = 0; s < nsteps; ++s) {
        if (s + 1 >= nsteps) asm volatile("s_waitcnt vmcnt(0)" ::: "memory");
        else if (s < 2) { if (widu == 7) asm volatile("s_waitcnt vmcnt(5)" ::: "memory"); else asm volatile("s_waitcnt vmcnt(8)" ::: "memory"); }
        else { if (widu == 7) asm volatile("s_waitcnt vmcnt(9)" ::: "memory"); else asm volatile("s_waitcnt vmcnt(12)" ::: "memory"); }
        SCAN_BAR();
        const unsigned char* sb = lds + (s & 1) * SC_SLOT;
        const bf16_t* STc = ST + (s & 1) * 32 * 136; bf16_t* STn = ST + ((s & 1) ^ 1) * 32 * 136;
        bf16x8 st[4], wf[4], qgf[4];
#pragma unroll
        for (int ks = 0; ks < 4; ++ks) { st[ks] = *(const bf16x8*)(STc + (nt * 16 + fr) * 136 + ks * 32 + fq * 8);
            wf[ks] = *(const bf16x8*)(sb + SC_W + (mt * 16 + fr) * 256 + (((ks * 4 + fq) ^ fr) * 16));
            qgf[ks] = *(const bf16x8*)(sb + SC_QG + (mt * 16 + fr) * 256 + (((ks * 4 + fq) ^ fr) * 16)); }
        const u32x2 uu = *(const u32x2*)(sb + SC_U + (nt * 16 + fr) * 128 + (((mt * 2 + (fq >> 1)) ^ (fr >> 1)) * 16) + (fq & 1) * 8);
        const float gl = *(const float*)(sb + SC_GL);
        f32x4 acc = {0.f, 0.f, 0.f, 0.f};
#pragma unroll
        for (int ks = 0; ks < 4; ++ks) acc = __builtin_amdgcn_mfma_f32_16x16x32_bf16(wf[ks], st[ks], acc, 0, 0, 0);
        asm volatile("s_nop 7\n\ts_nop 7" ::: "memory");
        float vn[4];
        vn[0] = __uint_as_float(uu.x << 16) - acc[0]; vn[1] = __uint_as_float(uu.x & 0xffff0000u) - acc[1]; vn[2] = __uint_as_float(uu.y << 16) - acc[2]; vn[3] = __uint_as_float(uu.y & 0xffff0000u) - acc[3];
        { u32x2 w; w.x = pk2(vn[0], vn[1]); w.y = pk2(vn[2], vn[3]); *(u32x2*)(VN + (nt * 16 + fr) * 72 + mt * 16 + fq * 4) = w; }
        f32x4 oc = {0.f, 0.f, 0.f, 0.f};
#pragma unroll
        for (int ks = 0; ks < 4; ++ks) oc = __builtin_amdgcn_mfma_f32_16x16x32_bf16(qgf[ks], st[ks], oc, 0, 0, 0);
        asm volatile("s_nop 7\n\ts_nop 7" ::: "memory");
#pragma unroll
        for (int n = 0; n < 2; ++n) S[n] *= gl;
        bf16x8 kdf[2], amf[2];
#pragma unroll
        for (int ks = 0; ks < 2; ++ks) { kdf[ks] = *(const bf16x8*)(sb + SC_KD + (wid * 16 + fr) * 128 + (((ks * 4 + fq) ^ (fr >> 1)) * 16));
            amf[ks] = *(const bf16x8*)(sb + SC_A + (mt * 16 + fr) * 128 + (((ks * 4 + fq) ^ (fr >> 1)) * 16)); }
        SCAN_BAR();
        if (s > 0) {
#pragma unroll
            for (int j = 0; j < 4; ++j) opv[(size_t)j * 1536] = ocv[j]; }
        if (s + 2 < nsteps) SCAN_ISSUE(s & 1);
#pragma unroll
        for (int n = 0; n < 2; ++n) {
#pragma unroll
            for (int ks = 0; ks < 2; ++ks) { const bf16x8 vb = *(const bf16x8*)(VN + (n * 16 + fr) * 72 + ks * 32 + fq * 8); S[n] = __builtin_amdgcn_mfma_f32_16x16x32_bf16(kdf[ks], vb, S[n], 0, 0, 0); asm volatile("s_nop 7\n\ts_nop 7" ::: "memory"); } }
#pragma unroll
        for (int n = 0; n < 2; ++n) { u32x2 w; w.x = pk2(S[n][0], S[n][1]); w.y = pk2(S[n][2], S[n][3]); *(u32x2*)(STn + (n * 16 + fr) * 136 + wid * 16 + fq * 4) = w; }
#pragma unroll
        for (int ks = 0; ks < 2; ++ks) { const bf16x8 vb = *(const bf16x8*)(VN + (nt * 16 + fr) * 72 + ks * 32 + fq * 8); oc = __builtin_amdgcn_mfma_f32_16x16x32_bf16(amf[ks], vb, oc, 0, 0, 0); asm volatile("s_nop 7\n\ts_nop 7" ::: "memory"); }
        opv = O + (size_t)(row00 + s * 64 + mt * 16 + fq * 4) * 1536 + h * 128 + es * 32 + nt * 16 + fr; ocv = oc;
    }
#pragma unroll
    for (int j = 0; j < 4; ++j) opv[(size_t)j * 1536] = ocv[j];
    __syncthreads();
    float* dp = seq == 0 ? a.out + O_DELTA_P + (size_t)h * 16384 : a.out + O_DELTA_S + (size_t)((seq - 1) * 12 + h) * 16384;
#pragma unroll
    for (int n = 0; n < 2; ++n)
#pragma unroll
        for (int j = 0; j < 4; ++j) dp[(size_t)(wid * 16 + fq * 4 + j) * 128 + es * 32 + n * 16 + fr] = S[n][j];
}

constexpr int AT_BUF = 65536;
constexpr int AT_KOFF = 0, AT_VOFF = 32768;
constexpr int AT_LUT = 2 * AT_BUF;
constexpr int AT_X = 0;
struct AttnItem {
    const bf16_t* q[2]; int ldq;
    const bf16_t* k[2]; int ldk;
    const bf16_t* vt[2]; int ldvt;
    int nkt;
    int qpos0;
    bf16_t* out; int ldo;
};
template <bool MEM>
__device__ __forceinline__ void attn_item(unsigned char* lds, const AttnItem& it, float lam, const float* subln, int tid_in) {
    constexpr int NETW = MEM ? 8 : 16;
    int tid_ = tid_in; asm volatile("" : "+v"(tid_));
    const int tid = tid_, lane = tid & 63, wid = tid >> 6, fr = lane & 15, fq = lane >> 4, g = wid >> 2, qr0 = (wid & 3) * 16;
    const int et0 = MEM ? 8 * g : 0;
    const float* LUT = (const float*)(lds + AT_LUT);
    const int widu = __builtin_amdgcn_readfirstlane(wid);
    bf16x8 qf[4];
#pragma unroll
    for (int ks = 0; ks < 4; ++ks) qf[ks] = *(const bf16x8*)((g ? it.q[1] : it.q[0]) + (size_t)(qr0 + fr) * it.ldq + ks * 32 + fq * 8);
    unsigned koff[8];
#pragma unroll
    for (int i = 0; i < 8; ++i) { const int n = widu * 8 + i;
        if (widu < 4) { const int row = (n & 15) * 4 + (lane >> 4), c16 = (lane & 15) ^ (row & 15); const int key = 32 * (row >> 5) + 8 * ((row >> 2) & 3) + 4 * ((row >> 4) & 1) + (row & 3);
            koff[i] = (unsigned)(key * it.ldk + c16 * 8) * 2u; }
        else { const int row = (n - 32) * 8 + (lane >> 3), c8 = (lane & 7) ^ ((row >> 1) & 7);
            koff[i] = (unsigned)((row & 127) * it.ldvt + c8 * 8) * 2u; } }
    const char* ksrc = (const char*)(widu < 2 ? it.k[0] : it.k[1]);
    const char* vsrc = (const char*)(widu < 6 ? it.vt[0] : it.vt[1]);
    const size_t kstep = (size_t)64 * it.ldk * 2;
#define ATT_ISSUE(kt_, bsel_) do { LAS unsigned char* dst_ = (LAS unsigned char*)lds + (bsel_) * AT_BUF + (widu < 4 ? AT_KOFF + widu * 8192 : AT_VOFF + (widu - 4) * 8192); \
        const char* src_ = widu < 4 ? ksrc + (size_t)(kt_) * kstep : vsrc + (size_t)(kt_) * 128; \
        _Pragma("unroll") for (int i = 0; i < 8; ++i) __builtin_amdgcn_global_load_lds((const unsigned*)(src_ + koff[i]), (LAS unsigned*)(dst_ + i * 1024), 16, 0, 0); } while (0)
#define ATT_BAR() do { asm volatile("s_waitcnt vmcnt(0) lgkmcnt(0)" ::: "memory"); __builtin_amdgcn_s_barrier(); asm volatile("" ::: "memory"); } while (0)
    f32x4 O[NETW];
#pragma unroll
    for (int e = 0; e < NETW; ++e) O[e] = (f32x4){0.f, 0.f, 0.f, 0.f};
    float mrun = -INFINITY, lsum = 0.f;
    const float sc = 0.08838834764831845f * LOG2E;
    __syncthreads();
    ATT_ISSUE(0, 0);
    for (int kt = 0; kt < it.nkt; ++kt) {
        const int bsel = kt & 1;
        ATT_BAR();
        if (kt + 1 < it.nkt) ATT_ISSUE(kt + 1, bsel ^ 1);
        const unsigned char* KTr = lds + bsel * AT_BUF + AT_KOFF; const unsigned char* VTr = lds + bsel * AT_BUF + AT_VOFF;
        f32x4 S[4];
#pragma unroll
        for (int t = 0; t < 4; ++t) S[t] = (f32x4){0.f, 0.f, 0.f, 0.f};
        {
            bf16x8 kf[4][4];
            const unsigned char* kb = KTr + g * 16384 + fr * 256;
#pragma unroll
            for (int ks = 0; ks < 4; ++ks)
#pragma unroll
                for (int t = 0; t < 4; ++t) kf[ks][t] = *(const bf16x8*)(kb + t * 4096 + (((ks * 4 + fq) ^ fr) * 16));
            __builtin_amdgcn_sched_barrier(0);
#pragma unroll
            for (int ks = 0; ks < 4; ++ks)
#pragma unroll
                for (int t = 0; t < 4; ++t) S[t] = __builtin_amdgcn_mfma_f32_16x16x32_bf16(kf[ks][t], qf[ks], S[t], 0, 0, 0);
        }
        u32x4 vf[2][8];
        const unsigned char* vbase = VTr + (et0 * 16 + fr) * 128;
#define ATT_LDV(buf, grp) do { _Pragma("unroll") for (int e4 = 0; e4 < 4; ++e4) _Pragma("unroll") for (int kb = 0; kb < 2; ++kb) \
            vf[buf][e4 * 2 + kb] = *(const u32x4*)(vbase + ((grp) * 4 + e4) * 2048 + (((kb * 4 + fq) ^ (fr >> 1)) * 16)); } while (0)
        __builtin_amdgcn_sched_barrier(0);
        ATT_LDV(0, 0);
        __builtin_amdgcn_sched_barrier(0);
        float mloc = -INFINITY;
        if (!MEM) {
            const int relb = kt * 64 + fq * 8 - (it.qpos0 + qr0 + fr);
            if (kt * 64 + 63 - (it.qpos0) <= -128) {
                const float bc = LUT[0];
#pragma unroll
                for (int t = 0; t < 4; ++t)
#pragma unroll
                    for (int j = 0; j < 4; ++j) { S[t][j] = S[t][j] * sc + bc; mloc = fmaxf(mloc, S[t][j]); }
            } else {
#pragma unroll
                for (int t = 0; t < 4; ++t)
#pragma unroll
                    for (int j = 0; j < 4; ++j) { int rel = relb + 32 * (t >> 1) + 4 * (t & 1) + j; rel = rel < -128 ? -128 : rel; S[t][j] = S[t][j] * sc + LUT[rel + 128]; mloc = fmaxf(mloc, S[t][j]); }
            }
        } else {
#pragma unroll
            for (int t = 0; t < 4; ++t)
#pragma unroll
                for (int j = 0; j < 4; ++j) { S[t][j] *= sc; mloc = fmaxf(mloc, S[t][j]); }
        }
        mloc = fmaxf(mloc, shx(mloc, 16, lane)); mloc = fmaxf(mloc, shx(mloc, 32, lane));
        if (__builtin_amdgcn_ballot_w64(mloc > mrun)) {
            const float mnew = fmaxf(mrun, mloc), alpha = __builtin_amdgcn_exp2f(mrun - mnew);
            mrun = mnew; lsum *= alpha;
#pragma unroll
            for (int e = 0; e < NETW; ++e) O[e] *= alpha;
        }
        float ps = 0.f;
#pragma unroll
        for (int t = 0; t < 4; ++t)
#pragma unroll
            for (int j = 0; j < 4; ++j) { S[t][j] = __builtin_amdgcn_exp2f(S[t][j] - mrun); ps += S[t][j]; }
        lsum += ps;
        bf16x8 pf[2];
#pragma unroll
        for (int kb = 0; kb < 2; ++kb) { u32x4 w; w.x = pk2(S[2 * kb][0], S[2 * kb][1]); w.y = pk2(S[2 * kb][2], S[2 * kb][3]); w.z = pk2(S[2 * kb + 1][0], S[2 * kb + 1][1]); w.w = pk2(S[2 * kb + 1][2], S[2 * kb + 1][3]);
            pf[kb] = __builtin_bit_cast(bf16x8, w); }
#pragma unroll
        for (int grp = 0; grp < NETW / 4; ++grp) {
            if (grp + 1 < NETW / 4) { if ((grp & 1) == 0) ATT_LDV(1, grp + 1); else ATT_LDV(0, grp + 1); }
            __builtin_amdgcn_sched_barrier(0);
#pragma unroll
            for (int e4 = 0; e4 < 4; ++e4)
#pragma unroll
                for (int kb = 0; kb < 2; ++kb) O[grp * 4 + e4] = __builtin_amdgcn_mfma_f32_16x16x32_bf16(__builtin_bit_cast(bf16x8, vf[grp & 1][e4 * 2 + kb]), pf[kb], O[grp * 4 + e4], 0, 0, 0);
            __builtin_amdgcn_sched_barrier(0);
        }
    }
    lsum += shx(lsum, 16, lane); lsum += shx(lsum, 32, lane);
    const float inv = 1.f / lsum;
    if (MEM) {
        bf16_t* op = it.out + (size_t)(qr0 + fr) * it.ldo + g * 128 + fq * 4;
#pragma unroll
        for (int e = 0; e < NETW; ++e) { u32x2 w; w.x = pk2(O[e][0] * inv, O[e][1] * inv); w.y = pk2(O[e][2] * inv, O[e][3] * inv); *(u32x2*)(op + e * 16) = w; }
    } else {
        float* X = (float*)(lds + AT_X);
        __syncthreads();
        if (g == 1) {
#pragma unroll
            for (int e = 0; e < NETW; ++e) *(f32x4*)(X + (qr0 + fr) * 260 + e * 16 + fq * 4) = O[e] * (inv * lam);
        }
        __syncthreads();
        if (g == 0) {
            float ss = 0.f;
#pragma unroll
            for (int e = 0; e < NETW; ++e) { const f32x4 x = *(const f32x4*)(X + (qr0 + fr) * 260 + e * 16 + fq * 4); O[e] = O[e] * inv - x; ss += (O[e][0] * O[e][0] + O[e][1] * O[e][1]) + (O[e][2] * O[e][2] + O[e][3] * O[e][3]); }
            ss += shx(ss, 16, lane); ss += shx(ss, 32, lane);
            const float rs = rsqrtf(ss * (1.f / 256.f) + EPSF) * (1.f - LAM0);
            bf16_t* op = it.out + (size_t)(qr0 + fr) * it.ldo + fq * 4;
#pragma unroll
            for (int e = 0; e < NETW; ++e) { const f32x4 gn = *(const f32x4*)(subln + e * 16 + fq * 4); u32x2 w; w.x = pk2(O[e][0] * rs * gn.x, O[e][1] * rs * gn.y); w.y = pk2(O[e][2] * rs * gn.z, O[e][3] * rs * gn.w); *(u32x2*)(op + e * 16) = w; }
        }
    }
}
__device__ __forceinline__ void mem_attn_item(unsigned char* lds, const Args& a, int l, int rt, int hp, const bf16_t* QB, int ldq, int qcol, int tid_in) {
    const int seq = rt < 256 ? 0 : rt - 255;
    const bf16_t* MK = (const bf16_t*)(a.ws + B_MK) + (size_t)(l * 9 + seq) * 4 * 256 * 128;
    const bf16_t* MVT = (const bf16_t*)(a.ws + B_MVT) + (size_t)(l * 9 + seq) * 4 * 256 * 128;
    AttnItem it; const int h0 = hp * 2;
    it.q[0] = QB + (size_t)rt * 64 * ldq + qcol + h0 * 128; it.q[1] = it.q[0] + 128; it.k[0] = MK + (size_t)h0 * 256 * 128; it.k[1] = it.k[0] + 256 * 128; it.vt[0] = MVT + (size_t)h0 * 128 * 256; it.vt[1] = it.vt[0] + 128 * 256;
    it.ldq = ldq; it.ldk = 128; it.ldvt = 256; it.nkt = 4; it.qpos0 = 0;
    it.out = (bf16_t*)(a.ws + B_MIX) + (size_t)rt * 64 * DM + 1536 + hp * 256; it.ldo = DM;
    attn_item<true>(lds, it, 0.f, nullptr, tid_in);
}

#define XB_TMO      128
#define XB_XCNT(j)  (256  + 64 * (j))
#define XB_XSUB(j)  (1280 + 64 * (j))
#define XB_XGEN(j)  (2304 + 64 * (j))
#define XB_TOP      3328
#define XB_TOPGEN   3392
#define XCD_BAR_WORDS 3456
#define XB_SPIN_CAP (1u << 18)


__device__ __forceinline__ unsigned xb_ld(unsigned* p)              { return __hip_atomic_load(p, __ATOMIC_RELAXED, __HIP_MEMORY_SCOPE_AGENT); }
__device__ __forceinline__ unsigned xb_add(unsigned* p, unsigned v) { return __hip_atomic_fetch_add(p, v, __ATOMIC_RELAXED, __HIP_MEMORY_SCOPE_AGENT); }
__device__ __forceinline__ unsigned xb_xcc_id() { return (unsigned)__builtin_amdgcn_s_getreg((3 << 11) | 20) & 0xFu; }
#define XB_SPIN(cond, bar) do { unsigned _sp = 0; while (cond) { __builtin_amdgcn_s_sleep(1); \
    if ((++_sp & 255u) == 0u) { if (xb_ld(&(bar)[XB_TMO])) break; if (_sp > XB_SPIN_CAP) { atomicAdd(&(bar)[XB_TMO], 1u); break; } } } } while (0)

struct XcdBarrier {
    unsigned* bar; unsigned x;
    volatile LAS unsigned* st;
};

__device__ __forceinline__ XcdBarrier xcd_barrier_post(unsigned* bar, volatile LAS unsigned* st) {
    XcdBarrier b; b.bar = bar; b.x = xb_xcc_id(); b.st = st;
    if (threadIdx.x == 0) (void)xb_add(&bar[XB_XCNT(b.x)], 1u);
    return b;
}
__device__ __forceinline__ void xcd_barrier_complete(unsigned* bar, unsigned x, unsigned& nloc, unsigned& nx) {
    const unsigned G = gridDim.x * gridDim.y * gridDim.z;
    unsigned sum, cnt, mine, sp = 0u;
    for (;;) {
        sum = 0u; cnt = 0u; mine = 0u;
#pragma unroll
        for (unsigned j = 0; j < 16; ++j) { const unsigned c = xb_ld(&bar[XB_XCNT(j)]); sum += c; cnt += (c > 0u) ? 1u : 0u; mine = (j == x) ? c : mine; }
        if (sum == G) break;
        __builtin_amdgcn_s_sleep(1);
        if ((++sp & 255u) == 0u) { if (xb_ld(&bar[XB_TMO])) break; if (sp > XB_SPIN_CAP) { atomicAdd(&bar[XB_TMO], 1u); break; } }
    }
    nloc = mine > 0u ? mine : 1u; nx = cnt > 0u ? cnt : 1u;
}

__device__ __forceinline__ void xcd_barrier(const XcdBarrier& b) {
    asm volatile("s_waitcnt vmcnt(0)" ::: "memory");
    __syncthreads();
    if (threadIdx.x == 0) {
        unsigned* bar = b.bar;
        __builtin_amdgcn_s_waitcnt(0);
        unsigned nloc = b.st[0], nx = b.st[1];
        if (nloc == 0u) { xcd_barrier_complete(bar, b.x, nloc, nx); b.st[0] = nloc; b.st[1] = nx; }
        const unsigned old = xb_add(&bar[XB_XSUB(b.x)], 1u);
        const unsigned gen = old / nloc;
        if (old + 1u == (gen + 1u) * nloc) {
            __builtin_amdgcn_fence(__ATOMIC_RELEASE, "agent");
            asm volatile("s_waitcnt vmcnt(0)" ::: "memory");
            const unsigned og = xb_add(&bar[XB_TOP], 1u);
            const unsigned tg = og / nx;
            if (og + 1u == (tg + 1u) * nx) xb_add(&bar[XB_TOPGEN], 1u);
            else XB_SPIN(xb_ld(&bar[XB_TOPGEN]) == tg, bar);
            __builtin_amdgcn_fence(__ATOMIC_ACQUIRE, "agent");
            xb_add(&bar[XB_XGEN(b.x)], 1u);
            asm volatile("s_waitcnt vmcnt(0)" ::: "memory");
        } else {
            XB_SPIN(xb_ld(&bar[XB_XGEN(b.x)]) == gen, bar);
            __builtin_amdgcn_fence(__ATOMIC_ACQUIRE, "agent");
            asm volatile("s_waitcnt vmcnt(0)" ::: "memory");
        }
    }
    __syncthreads();
}

constexpr int NPHASE = 24;
__global__ void __launch_bounds__(NT, 2) fwd_kernel(Args a0) {
    extern __shared__ __attribute__((aligned(16))) unsigned char lds[];
    cg::grid_group grid = cg::this_grid();
    LAS unsigned char* glds = (LAS unsigned char*)lds;
    const int hi = a0.ph_hi < NPHASE ? a0.ph_hi : NPHASE;
#ifndef REPMASK
#define REPMASK 0
#endif
    int rep = 0; const int repmask = a0.repmask;
    volatile LAS unsigned* xst = (volatile LAS unsigned*)(glds + LDS_BYTES - 16);
    if (threadIdx.x < 4) xst[threadIdx.x] = 0u;
    __syncthreads();
    const XcdBarrier xbar = xcd_barrier_post((unsigned*)(a0.ws + B_BAR), xst);
    const int wid0 = __builtin_amdgcn_readfirstlane(threadIdx.x >> 6);
#pragma unroll 1
    for (int ph = a0.ph_lo; ph < hi; ) {
        typedef const __attribute__((address_space(4))) char* kptr_t;
        kptr_t kp = (kptr_t)__builtin_amdgcn_kernarg_segment_ptr();
        int tid_ = wid0 * 64 + (int)__builtin_amdgcn_mbcnt_hi(~0u, __builtin_amdgcn_mbcnt_lo(~0u, 0u)), bid_ = blockIdx.x, G_ = gridDim.x;
        asm volatile("" : "+v"(tid_), "+s"(bid_), "+s"(G_), "+s"(kp));
        Args a;
#pragma unroll
        for (int i = 0; i < 26; ++i) a.in[i] = *(const float* const __attribute__((address_space(4)))*)(kp + 8 * i);
        a.out = *(float* const __attribute__((address_space(4)))*)(kp + 208); a.ws = *(unsigned char* const __attribute__((address_space(4)))*)(kp + 216); a.ph_lo = 0; a.ph_hi = 0;
        unsigned char* ws = a.ws;
        const int tid = tid_, bid = bid_, G = G_;
#define LANE_WID const int lane = tid & 63, wid = __builtin_amdgcn_readfirstlane(tid >> 6), gw = bid * 8 + wid, ngw = G * 8; (void)gw; (void)ngw; (void)wid; (void)lane;
        bf16_t* XN = (bf16_t*)(ws + B_XN); bf16_t* MIX = (bf16_t*)(ws + B_MIX); bf16_t* R1 = (bf16_t*)(ws + B_R1);
        float* Dbuf = (float*)(ws + B_R2);
        const float* NG = a.in[9];
        int kind;
        switch (ph) { case 0: kind = 0; break; case 3: case 9: case 12: case 16: case 20: case 23: kind = 2; break; case 5: kind = 3; break; case 6: kind = 4; break; case 7: kind = 5; break; case 18: kind = 6; break; default: kind = 1; }
        if (kind == 0) {
            LANE_WID
            float* scr = (float*)(lds + wid * 8704);
            conv_weight<1>(a.in[10], DM, NGU, NGU, (bf16_t*)(ws + W_GU), scr, gw, ngw, lane);
            conv_weight<0>(a.in[11], FF, DM, DM, (bf16_t*)(ws + W_DN), scr, gw, ngw, lane);
            conv_weight<0>(a.in[15], DM, INA, INA_P, (bf16_t*)(ws + W_INA), scr, gw, ngw, lane);
            for (int i = 0; i < 2; ++i) conv_weight<0>(a.in[14] + (size_t)i * DM * 1024, DM, 1024, 1024, (bf16_t*)(ws + W_MEM + (size_t)i * 1024 * DM * 2), scr, gw, ngw, lane);
            for (int r = gw; r < MT; r += ngw) row_update(xrow(a, r), a.out + (size_t)r * DM, nullptr, 0.f, nullptr, NG, XN + (size_t)r * DM, nullptr, nullptr, lane);
            for (int r = gw; r < 512; r += ngw) { const int l = r >> 8, mm = r & 255;
                row_update(a.in[2] + (size_t)mm * DM, nullptr, nullptr, 0.f, nullptr, a.in[13] + l * DM, (bf16_t*)(ws + B_MEMN) + (size_t)r * DM, nullptr, nullptr, lane); }
            const size_t gt = (size_t)bid * NT + tid, ngt = (size_t)G * NT;
            { bf16_t* MK = (bf16_t*)(ws + B_MK); bf16_t* MVT = (bf16_t*)(ws + B_MVT);
              for (size_t i = gt; i < (size_t)2 * 8 * 256 * 512; i += ngt) { const size_t d = i & 127, hh = (i >> 7) & 3, mm = (i >> 9) & 255, b = (i >> 17) & 7, l = i >> 20;
                  MK[(((l * 9 + 1 + b) * 4 + hh) * 256 + mm) * 128 + d] = f2bf(a.in[5][i]);
                  MVT[(((l * 9 + 1 + b) * 4 + hh) * 128 + d) * 256 + mm] = f2bf(a.in[6][i]); } }
        } else if (kind == 1) {
#pragma unroll 1
            for (int sub = 0; sub < 2; ++sub) {
                const bf16_t* A = nullptr; const bf16_t* B = nullptr; int M = MT, N = DM, K = DM, Gs = G, c = bid, ld = 0, mt = 1 << 20, ksl = 0; EpiBase E{0, nullptr, nullptr, nullptr, nullptr, DM};
                const bool split = ph == 2 || ph == 11 || ph == 15 || ph == 22 || ph == 8 || ph == 19;
                const int l = ph >= 13 ? 1 : 0;
                if (sub == 1) {
                    if (ph == 1) {
                        c = bid - (G - 8); if (c < 0) break; const int ll = c >> 2; c &= 3; Gs = 4; M = 256; N = 1024;
                        A = (const bf16_t*)(ws + B_MEMN) + (size_t)ll * 256 * DM; B = (const bf16_t*)(ws + W_MEM) + (size_t)ll * 1024 * DM;
                        E.mode = 4; E.f0 = a.out + O_MK_P + (size_t)ll * 256 * 512; E.f1 = a.out + O_MV_P + (size_t)ll * 256 * 512;
                    } else if (split) {
                        const int Kf = (ph == 8 || ph == 19) ? DM : FF; const int lyr = ph >= 13 ? 1 : 0;
                        if (ph == 8 || ph == 19) { A = MIX; B = (const bf16_t*)(ws + W_OUT + (size_t)lyr * SZ_WSQ); }
                        else { const int i = (ph == 2 || ph == 15) ? 0 : 1; A = R1; B = (const bf16_t*)(ws + W_DN + (size_t)(lyr * 2 + i) * SZ_WDN); }
                        A += (size_t)MP * Kf; M = (Kf / 512) * 512; K = 512; ld = Kf; mt = 2; ksl = 512; E.mode = 0; E.f0 = (float*)(ws + B_DP); E.ldc = DM;
                    } else break;
                } else {
                    switch (ph) {
                        case 1: case 10: case 14: case 21: { const int i = (ph == 1 || ph == 14) ? 0 : 1; A = XN; B = (const bf16_t*)(ws + W_GU + (size_t)(l * 2 + i) * SZ_WGU); N = NGU; E.mode = 1; E.b0 = R1; } break;
                        case 2: case 11: case 15: case 22: { const int i = (ph == 2 || ph == 15) ? 0 : 1; A = R1; B = (const bf16_t*)(ws + W_DN + (size_t)(l * 2 + i) * SZ_WDN); K = FF; E.mode = 2; E.b0 = (bf16_t*)Dbuf; E.ldc = DM; E.f0 = nullptr; } break;
                        case 4: A = XN; B = (const bf16_t*)(ws + W_INA); N = INA_P; E.mode = 2; E.b0 = R1; E.ldc = INA_P; E.f0 = (float*)(ws + B_LOG); break;
                        case 8: case 19: A = MIX; B = (const bf16_t*)(ws + W_OUT + (size_t)l * SZ_WSQ); E.mode = 2; E.b0 = (bf16_t*)Dbuf; E.ldc = DM; E.f0 = nullptr; break;
                        case 13: A = MIX; B = (const bf16_t*)(ws + W_KV); N = NKV; E.mode = 3; E.f0 = a.out; break;
                        default:   A = XN; B = (const bf16_t*)(ws + W_INB); N = INB; E.mode = 2; E.b0 = R1; E.ldc = INB; E.f0 = nullptr; break;
                    }
                }
                if (sub == 0 && split) M = MP;
                if (ld == 0) ld = K;
                pg8::Gemm g_{A, B, M, N, K, ld, mt, ksl}; pg8::StaticOrder S_; S_.init(M, N, Gs, c);
                if (E.mode == 1) { EpiSwigluG E1; *(EpiBase*)&E1 = E; pg8::gemm_phase<EpiSwigluG, pg8::StaticOrder, true, true>(glds, g_, S_, E1, tid); }
                else if (E.mode == 2) { EpiBf16G E2; *(EpiBase*)&E2 = E; pg8::gemm_phase<EpiBf16G, pg8::StaticOrder, true, true>(glds, g_, S_, E2, tid); }
                else { EpiF32G E0; *(EpiBase*)&E0 = E; pg8::gemm_phase<EpiF32G, pg8::StaticOrder, true, true>(glds, g_, S_, E0, tid); }
            }
        } else if (kind == 2) {
            LANE_WID
            const int l = ph >= 13 ? 1 : 0; const float* ng = NG + (size_t)l * 6 * DM;
            float coef = 0.5f; const float* g1; const float* g2; const float* g3 = nullptr;
            switch (ph) {
                case 3: case 16: g1 = ng + DM; g2 = ng + 2 * DM; break;
                case 9: case 20: coef = 1.0f; g1 = ng + 3 * DM; g2 = ng + 4 * DM; break;
                case 12: g1 = ng + 5 * DM; g2 = NG + 6 * DM; g3 = a.in[20]; break;
                default: g1 = ng + 5 * DM; g2 = nullptr; break;
            }
            phase_rowpass(a, Dbuf, coef, g1, g2, g3, gw, ngw, lane, (ph == 9 || ph == 20) ? 4 : 11);
            if (ph == 3) {
                bf16_t* MK = (bf16_t*)(ws + B_MK); bf16_t* MVT = (bf16_t*)(ws + B_MVT);
                for (size_t i = (size_t)bid * NT + tid; i < (size_t)2 * 256 * 512; i += (size_t)G * NT) { const size_t d = i & 127, hh = (i >> 7) & 3, mm = (i >> 9) & 255, l2 = i >> 17;
                    MK[(((l2 * 9) * 4 + hh) * 256 + mm) * 128 + d] = f2bf(a.out[O_MK_P + i]);
                    MVT[(((l2 * 9) * 4 + hh) * 128 + d) * 256 + mm] = f2bf(a.out[O_MV_P + i]); }
            }
            if (ph == 16) {
                float* scr = (float*)(lds + wid * 8704);
                conv_weight<0>(a.out + O_V_P, MP, 1536, 1536, (bf16_t*)(ws + B_VTP), scr, gw, ngw, lane);
                for (int b = 0; b < 8; ++b) conv_weight<0>(a.out + O_V_S + (size_t)b * 64 * 1536, 64, 1536, 1536, (bf16_t*)(ws + B_VTS) + (size_t)b * 1536 * 1088 + 1024, scr, gw, ngw, lane, 1088);
                const size_t gt = (size_t)bid * NT + tid, ngt = (size_t)G * NT;
                bf16_t* KP = (bf16_t*)(ws + B_KP); bf16_t* KS = (bf16_t*)(ws + B_KS);
                for (size_t i = gt; i < (size_t)MT * 192; i += ngt) { const size_t r = i / 192, c8 = i % 192;
                    const float* sp = (r < MP ? a.out + O_K_P + r * 1536 : a.out + O_K_S + (r - MP) * 1536) + c8 * 8;
                    const f32x4 x0 = *(const f32x4*)sp, x1 = *(const f32x4*)(sp + 4);
                    u32x4 w; w.x = pk2(x0.x, x0.y); w.y = pk2(x0.z, x0.w); w.z = pk2(x1.x, x1.y); w.w = pk2(x1.z, x1.w);
                    bf16_t* dp = r < MP ? KP + r * 1536 : KS + (((r - MP) >> 6) * 1088 + 1024 + ((r - MP) & 63)) * 1536;
                    *(u32x4*)(dp + c8 * 8) = w; }
            }
        } else if (kind == 3) {
            for (int it = bid; it < NITEM; it += G) gdn_prep_item(lds, a, it / 12, it % 12, tid);
            const size_t gt = (size_t)bid * NT + tid, ngt = (size_t)G * NT;
            for (size_t i = gt; i < (size_t)9 * 3 * 4608; i += ngt) { const int s = (int)(i / (3 * 4608)), rem = (int)(i % (3 * 4608)), j = rem / 4608, ch = rem % 4608;
                const int row = s == 0 ? MP - 3 + j : MP + (s - 1) * 64 + 61 + j;
                const float x = bf2f(R1[(size_t)row * INA_P + ch]);
                if (s == 0) a.out[O_CONV_P + rem] = x; else a.out[O_CONV_S + (size_t)(s - 1) * 3 * 4608 + rem] = x; }
        } else if (kind == 4) {
            const int c = bid - 48, GC = G - 48;
            for (int it = bid < 48 ? bid : 48 + c; it < 48 + 384; it += (bid < 48 ? 1 << 30 : GC)) {
                const int seq = it < 48 ? 0 : 1 + (it - 48) / 48, hh = it < 48 ? it >> 2 : ((it - 48) % 48) >> 2, es = it & 3;
                gdn_scan_item(lds, a, seq, hh, es, tid); __syncthreads(); }
            if (bid >= 48) for (int it = c; it < 528; it += GC) { mem_attn_item(lds, a, 0, it >> 1, it & 1, R1, INA_P, QMA, tid); __syncthreads(); }
            if (bid >= 48) {
                const int lane = tid & 63, wid = __builtin_amdgcn_readfirstlane(tid >> 6), gw2 = c * 8 + wid, ngw2 = GC * 8;
                float* scr = (float*)(lds + wid * 8704);
                for (int i = 1; i < 4; ++i) conv_weight<1>(a.in[10] + (size_t)i * DM * NGU, DM, NGU, NGU, (bf16_t*)(ws + W_GU + i * SZ_WGU), scr, gw2, ngw2, lane);
                for (int i = 1; i < 4; ++i) conv_weight<0>(a.in[11] + (size_t)i * FF * DM, FF, DM, DM, (bf16_t*)(ws + W_DN + i * SZ_WDN), scr, gw2, ngw2, lane);
                for (int i = 0; i < 2; ++i) conv_weight<0>(a.in[12] + (size_t)i * DM * DM, DM, DM, DM, (bf16_t*)(ws + W_OUT + i * SZ_WSQ), scr, gw2, ngw2, lane);
                conv_weight<0>(a.in[21], DM, NKV, NKV, (bf16_t*)(ws + W_KV), scr, gw2, ngw2, lane);
                conv_weight<0>(a.in[22], DM, INB, INB, (bf16_t*)(ws + W_INB), scr, gw2, ngw2, lane);
                for (int b = 0; b < 8; ++b) conv_weight<0>(a.in[4] + (size_t)b * 1024 * 1536, 1024, 1536, 1536, (bf16_t*)(ws + B_VTS) + (size_t)b * 1536 * 1088, scr, gw2, ngw2, lane, 1088);
                bf16_t* KS = (bf16_t*)(ws + B_KS);
                for (size_t i = (size_t)c * NT + tid; i < (size_t)8 * 1024 * 192; i += (size_t)GC * NT) { const size_t b = i / (1024 * 192), rem = i % (1024 * 192);
                    const f32x4 x0 = *(const f32x4*)(a.in[3] + i * 8), x1 = *(const f32x4*)(a.in[3] + i * 8 + 4);
                    u32x4 w; w.x = pk2(x0.x, x0.y); w.y = pk2(x0.z, x0.w); w.z = pk2(x1.x, x1.y); w.w = pk2(x1.z, x1.w);
                    *(u32x4*)(KS + b * 1088 * 1536 + rem * 8) = w; }
            }
        } else if (kind == 5) {
            const int lane = tid & 63;
            const float* O = (const float*)(ws + B_O); const float* on = a.in[19];
            const size_t gt = (size_t)bid * NT + tid, ngt = (size_t)G * NT;
            for (size_t i = gt; i < (size_t)MT * 192; i += ngt) { const size_t r = i / 192; const int hs = (int)(i % 192), hh = hs >> 4, sub = hs & 15;
                const float* op = O + r * 1536 + hh * 128 + sub * 8; const f32x4 o0 = *(const f32x4*)op, o1 = *(const f32x4*)(op + 4);
                float ss = (o0.x * o0.x + o0.y * o0.y) + (o0.z * o0.z + o0.w * o0.w) + (o1.x * o1.x + o1.y * o1.y) + (o1.z * o1.z + o1.w * o1.w);
                ss += shx(ss, 1, lane); ss += shx(ss, 2, lane); ss += shx(ss, 4, lane); ss += shx(ss, 8, lane);
                const float rs = rsqrtf(ss * (1.f / 128.f) + EPSF);
                const u32x4 zz = *(const u32x4*)(R1 + r * INA_P + 4608 + hh * 128 + sub * 8);
                const f32x4 g0 = *(const f32x4*)(on + sub * 8), g1 = *(const f32x4*)(on + sub * 8 + 4);
                float z[8]; z[0] = __uint_as_float(zz.x << 16); z[1] = __uint_as_float(zz.x & 0xffff0000u); z[2] = __uint_as_float(zz.y << 16); z[3] = __uint_as_float(zz.y & 0xffff0000u);
                z[4] = __uint_as_float(zz.z << 16); z[5] = __uint_as_float(zz.z & 0xffff0000u); z[6] = __uint_as_float(zz.w << 16); z[7] = __uint_as_float(zz.w & 0xffff0000u);
                u32x4 w; w.x = pk2(o0.x * rs * g0.x * siluf(z[0]), o0.y * rs * g0.y * siluf(z[1])); w.y = pk2(o0.z * rs * g0.z * siluf(z[2]), o0.w * rs * g0.w * siluf(z[3]));
                w.z = pk2(o1.x * rs * g1.x * siluf(z[4]), o1.y * rs * g1.y * siluf(z[5])); w.w = pk2(o1.z * rs * g1.z * siluf(z[6]), o1.w * rs * g1.w * siluf(z[7]));
                *(u32x4*)(MIX + r * DM + hh * 128 + sub * 8) = w; }
        } else {
            LANE_WID
            const float* lq = a.in[23];
            const float d0 = wave_sum(lq[lane] * lq[128 + lane] + lq[64 + lane] * lq[192 + lane], lane);
            const float d1 = wave_sum(lq[256 + lane] * lq[384 + lane] + lq[320 + lane] * lq[448 + lane], lane);
            const float lam = __expf(d0) - __expf(d1) + LAM0;
            const bf16_t* KP = (const bf16_t*)(ws + B_KP); const bf16_t* VTP = (const bf16_t*)(ws + B_VTP);
            const bf16_t* KS = (const bf16_t*)(ws + B_KS); const bf16_t* VTS = (const bf16_t*)(ws + B_VTS);
            float* LUT = (float*)(lds + AT_LUT);
            const int NPI = 256 * 6, NSI = 48, NMI = 528;
            const int nit = (G == 256) ? 7 : (NPI + NSI + G - 1) / G;
            for (int rnd = 0; rnd < nit; ++rnd) {
                int idx;
                if (G == 256) {
                    if (rnd < 6) { const int xcd = bid & 7, slot = bid >> 3; const int qb = (rnd & 1) ? 7 - xcd : xcd, s = (rnd & 1) ? 31 - slot : slot; idx = (255 - (qb * 32 + s)) * 6 + rnd; }
                    else idx = NPI + bid;
                } else { const int pos = (rnd & 1) ? (G - 1 - bid) : bid; idx = rnd * G + pos; }
                if (idx >= NPI + NSI) continue;
                __syncthreads();
                AttnItem it; int h;
                if (idx < NPI) { const int qt = 255 - idx / 6; h = idx % 6;
                    it.q[0] = R1 + (size_t)qt * 64 * INB + (h * 2) * 128; it.q[1] = it.q[0] + 128; it.k[0] = KP + (h * 2) * 128; it.k[1] = it.k[0] + 128; it.vt[0] = VTP + (size_t)(h * 256) * MP; it.vt[1] = it.vt[0] + (size_t)128 * MP;
                    it.ldq = INB; it.ldk = 1536; it.ldvt = MP; it.nkt = qt + 1; it.qpos0 = qt * 64; it.out = MIX + (size_t)qt * 64 * DM + h * 256; it.ldo = DM;
                } else { const int si = idx - NPI, b = si / 6; h = si % 6;
                    it.q[0] = R1 + (size_t)(MP + b * 64) * INB + (h * 2) * 128; it.q[1] = it.q[0] + 128; it.k[0] = KS + (size_t)b * 1088 * 1536 + (h * 2) * 128; it.k[1] = it.k[0] + 128;
                    it.vt[0] = VTS + ((size_t)b * 1536 + h * 256) * 1088; it.vt[1] = it.vt[0] + (size_t)128 * 1088;
                    it.ldq = INB; it.ldk = 1536; it.ldvt = 1088; it.nkt = 17; it.qpos0 = 1024; it.out = MIX + (size_t)(MP + b * 64) * DM + h * 256; it.ldo = DM;
                }
                if (tid < 192) { const int rel = tid - 128, n = rel < 0 ? -rel : rel; int bk;
                    if (n < 8) bk = n; else { int lg = 8 + (int)(__logf((float)n * 0.125f) / 2.772588722239781f * 8.f); bk = lg < 15 ? lg : 15; }
                    if (rel > 0) bk += 16;
                    LUT[tid] = a.in[25][bk * 6 + h] * LOG2E; }
                attn_item<false>(lds, it, lam, a.in[24], tid);
            }
            __syncthreads();
            { const int m0 = G > 96 ? bid - 48 : G - 1 - bid, ms = G > 96 ? G - 48 : G;
              for (int mi = m0; mi >= 0 && mi < NMI; mi += ms) { mem_attn_item(lds, a, 1, mi >> 1, mi & 1, R1, INB, 1536, tid); __syncthreads(); } }
        }
        if (a0.ph_lo < 0) grid.sync();
        if ((ph + 1 < hi) || (((repmask >> kind) & 1) && rep == 0)) xcd_barrier(xbar);
        if (((repmask >> kind) & 1) && rep == 0) rep = 1; else { rep = 0; ++ph; }
    }
}

extern "C" void kernel_launch(void* const* d_in, const int* in_sizes, int n_in, void* d_out, int out_size, void* d_ws, size_t ws_size, hipStream_t stream) {
    static int grid = 0;
    if (grid == 0) {
        int dev = 0, cus = 0, per_cu = 0;
        hipGetDevice(&dev);
        hipDeviceGetAttribute(&cus, hipDeviceAttributeMultiprocessorCount, dev);
        hipFuncSetAttribute((const void*)fwd_kernel, hipFuncAttributeMaxDynamicSharedMemorySize, LDS_BYTES);
        hipOccupancyMaxActiveBlocksPerMultiprocessor(&per_cu, (const void*)fwd_kernel, NT, LDS_BYTES);
        if (per_cu < 1) { fprintf(stderr, "kernel_launch: occupancy query says %d blocks/CU\n", per_cu); per_cu = 1; }
        grid = cus;
        if (ws_size < WS_END) { fprintf(stderr, "kernel_launch: workspace too small: %zu < %zu\n", ws_size, (size_t)WS_END); grid = -1; }
        if (n_in != 26) { fprintf(stderr, "kernel_launch: expected 26 inputs, got %d\n", n_in); grid = -1; }
    }
    if (grid < 0) return;
    Args a{};
    for (int i = 0; i < 26; ++i) a.in[i] = (const float*)d_in[i];
    a.out = (float*)d_out; a.ws = (unsigned char*)d_ws; a.ph_lo = 0; a.ph_hi = NPHASE; a.repmask = REPMASK; a.pad = 0;
    if (hipMemsetAsync((char*)d_ws + B_BAR, 0, 16384, stream) != hipSuccess) fprintf(stderr, "kernel_launch: memset of the barrier words failed\n");
    void* args[] = {&a};
    hipError_t e = hipLaunchCooperativeKernel((const void*)fwd_kernel, dim3(grid), dim3(NT), args, LDS_BYTES, stream);
    if (e != hipSuccess) fprintf(stderr, "cooperative launch failed: %s (grid %d)\n", hipGetErrorString(e), grid);
}
```
